# Optimizing an MI355X kernel written in HIP

```python
import math
import jax, jax.numpy as jnp
from jax import lax
import numpy as np

D_MODEL = 1024
BATCH = 2
SEQ = 8192
DEPTH = 2

CHUNK = 64
CONV_WIDTH = 512
CONV_GROUPS = 8
CONV_TAPS = 3
N_HEADS = 8
HEAD_DIM = 64
ATTN_WIDTH = N_HEADS * HEAD_DIM
D_FF = 4 * D_MODEL
Q_BLOCK = 128
N_MOD = 6
EPS = 1e-6
IN_COLS = 3 * CONV_WIDTH + 3 * ATTN_WIDTH + 2 * D_MODEL

kernel_name = "hybrid_shortconv_stickbreaking_block"


def rms_norm(x, g):
    xf = x.astype(jnp.float32)
    y = xf * lax.rsqrt(jnp.mean(xf * xf, axis=-1, keepdims=True) + EPS)
    return (y * g.astype(jnp.float32)).astype(x.dtype)


def modulate(h, shift, scale):
    return h * (1.0 + scale[:, None, :]) + shift[:, None, :]


def short_conv_branch(b_gate, c_gate, u, conv_w):
    s = u.shape[1]
    v = c_gate * u
    vp = jnp.pad(v, ((0, 0), (CONV_TAPS - 1, 0), (0, 0)))
    y = sum(conv_w[k] * vp[:, k:k + s, :] for k in range(CONV_TAPS))
    return b_gate * y


def stick_breaking_attention(q, k, v):
    b, s, h, dh = q.shape
    qh = jnp.transpose(q, (0, 2, 1, 3))
    kh = jnp.transpose(k, (0, 2, 1, 3))
    vh = jnp.transpose(v, (0, 2, 1, 3))
    inv_sqrt = 1.0 / math.sqrt(dh)
    key_pos = jnp.arange(s)
    n_blocks = s // Q_BLOCK

    def block(i):
        start = i * Q_BLOCK
        q_blk = lax.dynamic_slice_in_dim(qh, start, Q_BLOCK, axis=2)
        z = jnp.einsum('bhqd,bhkd->bhqk', q_blk, kh).astype(jnp.float32) * inv_sqrt
        q_pos = start + jnp.arange(Q_BLOCK)
        mask = key_pos[None, :] < q_pos[:, None]
        log_1m_beta = jnp.where(mask, jax.nn.log_sigmoid(-z), 0.0)
        suffix = lax.cumsum(log_1m_beta, axis=3, reverse=True) - log_1m_beta
        a = jnp.where(mask, jnp.exp(jax.nn.log_sigmoid(z) + suffix), 0.0)
        return jnp.einsum('bhqk,bhkd->bhqd', a, vh.astype(jnp.float32)).astype(q.dtype)

    o = lax.map(block, jnp.arange(n_blocks))
    o = jnp.transpose(o, (1, 0, 3, 2, 4))
    return o.reshape(b, s, h * dh)


def setup_inputs(seed: int = 0) -> dict:
    key = jax.random.key(seed)
    ks = jax.random.split(key, 16)
    f32 = jnp.float32
    L, D = DEPTH, D_MODEL

    def nrm(k, shape, fan_in):
        return jax.random.normal(k, shape, f32) * (fan_in ** -0.5)

    def gain(k):
        return 1.0 + 0.05 * jax.random.normal(k, (L, D), f32)

    return {
        "x": jax.random.normal(ks[0], (BATCH, SEQ, D), f32),
        "c": jax.random.normal(ks[1], (BATCH, D), f32),
        "w_ada": nrm(ks[2], (L, D, N_MOD * D), D) * 0.5,
        "b_ada": 0.01 * jax.random.normal(ks[3], (L, N_MOD * D), f32),
        "g_pre_mix": gain(ks[4]),
        "g_post_mix": gain(ks[5]),
        "g_pre_mlp": gain(ks[6]),
        "g_post_mlp": gain(ks[7]),
        "w_in": nrm(ks[8], (L, D, IN_COLS), D),
        "conv_w": nrm(ks[9], (L, CONV_TAPS, CONV_WIDTH), CONV_TAPS),
        "w_proj_conv": nrm(ks[10], (L, CONV_WIDTH, D), CONV_WIDTH),
        "w_proj_attn": nrm(ks[11], (L, ATTN_WIDTH, D), ATTN_WIDTH),
        "w_out": nrm(ks[12], (L, D, D), D),
        "w_mlp_in": nrm(ks[13], (L, D, D_FF), D),
        "w_mlp_out": nrm(ks[14], (L, D_FF, D), D_FF),
    }


def reference(x, c, w_ada, b_ada, g_pre_mix, g_post_mix, g_pre_mlp, g_post_mlp,
              w_in, conv_w, w_proj_conv, w_proj_attn, w_out, w_mlp_in, w_mlp_out):
    b, s, d = x.shape
    split_pts = np.cumsum([CONV_WIDTH, CONV_WIDTH, CONV_WIDTH,
                           ATTN_WIDTH, ATTN_WIDTH, ATTN_WIDTH, D_MODEL])
    for l in range(DEPTH):
        mod = c @ w_ada[l] + b_ada[l]
        sh1, sc1, gt1, sh2, sc2, gt2 = jnp.split(mod, N_MOD, axis=-1)

        h = modulate(rms_norm(x, g_pre_mix[l]), sh1, sc1)
        proj = h @ w_in[l]
        bg, cg, u, q, k, v, ga, gb = jnp.split(proj, split_pts, axis=-1)
        y_conv = short_conv_branch(bg, cg, u, conv_w[l]) @ w_proj_conv[l]
        o = stick_breaking_attention(q.reshape(b, s, N_HEADS, HEAD_DIM),
                                     k.reshape(b, s, N_HEADS, HEAD_DIM),
                                     v.reshape(b, s, N_HEADS, HEAD_DIM))
        y_attn = o @ w_proj_attn[l]
        merged = jax.nn.sigmoid(ga) * y_conv + jax.nn.sigmoid(gb) * y_attn
        mix_out = merged @ w_out[l]
        x = x + gt1[:, None, :] * rms_norm(mix_out, g_post_mix[l])

        h2 = modulate(rms_norm(x, g_pre_mlp[l]), sh2, sc2)
        ff = jnp.square(jax.nn.relu(h2 @ w_mlp_in[l])) @ w_mlp_out[l]
        x = x + gt2[:, None, :] * rms_norm(ff, g_post_mlp[l])
    return x
```

```cpp
#include <hip/hip_runtime.h>
#include <hip/hip_cooperative_groups.h>
#include <cstdio>
#include <cstdint>
namespace cg = cooperative_groups;

#ifndef MULTI_LAUNCH
#define MULTI_LAUNCH 0
#endif

#define LAS __attribute__((address_space(3)))
typedef unsigned short bf16_t;
typedef short bf16x8 __attribute__((ext_vector_type(8)));
typedef _Float16 half8 __attribute__((ext_vector_type(8)));
typedef float f32x4 __attribute__((ext_vector_type(4)));
typedef float f32x2 __attribute__((ext_vector_type(2)));
typedef float f32x16 __attribute__((ext_vector_type(16)));
typedef unsigned u32x4 __attribute__((ext_vector_type(4)));
typedef unsigned u32x2 __attribute__((ext_vector_type(2)));
typedef short s16x4 __attribute__((ext_vector_type(4)));

constexpr int DM = 1024, SEQ = 8192, NB = 2, MT = NB * SEQ, INC = 5120, CWID = 512, FF = 4096, NMOD = 6;
constexpr float EPS = 1e-6f;
constexpr float LOG2E = 1.4426950408889634f;
constexpr float QSCALE = 0.125f * LOG2E;
constexpr float EXIT_THR = -160.0f;

constexpr size_t MiB = 1u << 20;
constexpr size_t WS_MOD = 0;
constexpr size_t WS_W = 2 * MiB;
constexpr size_t WL_IN = 0, WL_PC = 10 * MiB, WL_PA = 11 * MiB, WL_OUT = 12 * MiB, WL_W1 = 14 * MiB, WL_W2 = 22 * MiB, WL_SZ = 30 * MiB;
constexpr size_t WS_XN = 62 * MiB;
constexpr size_t WS_PROJ = 94 * MiB;
constexpr size_t WS_END = 254 * MiB;

typedef __bf16 bf16x2_t __attribute__((ext_vector_type(2)));
__device__ __forceinline__ unsigned cvt_pk_bf16(float lo, float hi) { f32x2 v = {lo, hi}; bf16x2_t b = __builtin_convertvector(v, bf16x2_t); return __builtin_bit_cast(unsigned, b); }
__device__ __forceinline__ float bf_lo(unsigned w) { return __builtin_bit_cast(float, w << 16); }
__device__ __forceinline__ float bf_hi(unsigned w) { return __builtin_bit_cast(float, w & 0xffff0000u); }
__device__ __forceinline__ float fast_sigmoid(float v) { return __builtin_amdgcn_rcpf(1.0f + __builtin_amdgcn_exp2f(-v * LOG2E)); }

namespace pg8 {
constexpr int BM = 256, BK = 64, HALF = 128, HTB = HALF * BK * 2, STAGE_BYTES = 8 * HTB, NXCD = 8, WGM = 8;
__host__ __device__ __forceinline__ int lds_byte(int r, int c) { const int st = (r >> 4) * 2 + (c >> 5), rr = r & 15, cc = c & 31, ob = rr * 64 + cc * 2; return st * 1024 + (ob ^ (((ob >> 9) & 1) << 5)); }
__host__ __device__ __forceinline__ void stage_rc(int b, int& R, int& C) { const int st = b / 1024, sb = b % 1024, swz = sb ^ (((sb >> 9) & 1) << 5); R = (st >> 1) * 16 + swz / 64; C = (st & 1) * 32 + (swz % 64) / 2; }
__host__ __device__ __forceinline__ int perm32(int rho) { const int n = rho >> 4, i = rho & 15; return 8 * (i >> 2) + 4 * n + (i & 3); }
struct Unit { int pm, pn; };
struct Gemm { const bf16_t* A; const bf16_t* Bt; int M, N, K, lda; };
struct StaticOrder {
    int nM, nN, nwg, G, c;
    __device__ void init(int M, int N, int G_, int c_) { nM = M / BM; nN = N / BM; nwg = nM * nN; G = G_; c = c_; }
    __device__ bool next(int i, Unit& u) const {
        const long L = (long)i * G + c; if (L >= nwg) return false;
        int wgid = (int)L; { const int q = nwg / NXCD, r = nwg % NXCD, xcd = wgid % NXCD, off = wgid / NXCD; wgid = (xcd < r ? xcd * (q + 1) : r * (q + 1) + (xcd - r) * q) + off; }
        const int nig = WGM * nN, gid = wgid / nig, fm = gid * WGM, gsz = (nM - fm) < WGM ? (nM - fm) : WGM;
        u.pm = fm + ((wgid % nig) % gsz); u.pn = (wgid % nig) / gsz; return true;
    }
};
struct Epi {
    bf16_t* O; int ldc; int mode; const bf16_t* Gt; int ldg;
    __device__ __forceinline__ void operator()(const f32x4 (&acc)[2][2][4][2], const Unit& u, int wr, int wc, int fr, int fq) const {
        const int row0 = u.pm * BM + wr * 64 + fr; const int col0 = u.pn * BM + wc * 32 + 8 * fq;
        int m1 = 0; float sc = 1.f;
        if (mode == 1) { if (u.pn >= 12) m1 = 1; else if (u.pn == 6 || u.pn == 7) sc = QSCALE; }
#pragma unroll
        for (int ai = 0; ai < 2; ++ai)
#pragma unroll
            for (int m = 0; m < 4; ++m) {
                const size_t row = (size_t)(row0 + ai * HALF + m * 16);
                bf16_t* rowp = O + row * ldc + col0;
#pragma unroll
                for (int bj = 0; bj < 2; ++bj) {
                    f32x4 v0 = acc[ai][bj][m][0], v1 = acc[ai][bj][m][1];
                    if (mode == 1) {
                        if (m1) {
#pragma unroll
                            for (int i = 0; i < 4; ++i) { v0[i] = fast_sigmoid(v0[i]); v1[i] = fast_sigmoid(v1[i]); }
                        } else { v0 = v0 * sc; v1 = v1 * sc; }
                    } else if (mode == 2) {
#pragma unroll
                        for (int i = 0; i < 4; ++i) { const float a = fmaxf(v0[i], 0.f), b = fmaxf(v1[i], 0.f); v0[i] = a * a; v1[i] = b * b; }
                    } else if (mode >= 3) {
                        const u32x4 g = *(const u32x4*)(Gt + row * ldg + col0 + bj * HALF);
                        v0[0] *= bf_lo(g.x); v0[1] *= bf_hi(g.x); v0[2] *= bf_lo(g.y); v0[3] *= bf_hi(g.y);
                        v1[0] *= bf_lo(g.z); v1[1] *= bf_hi(g.z); v1[2] *= bf_lo(g.w); v1[3] *= bf_hi(g.w);
                        if (mode == 4) {
                            const u32x4 p = *(const u32x4*)(rowp + bj * HALF);
                            v0[0] += bf_lo(p.x); v0[1] += bf_hi(p.x); v0[2] += bf_lo(p.y); v0[3] += bf_hi(p.y);
                            v1[0] += bf_lo(p.z); v1[1] += bf_hi(p.z); v1[2] += bf_lo(p.w); v1[3] += bf_hi(p.w);
                        }
                    }
                    u32x4 w; w.x = cvt_pk_bf16(v0[0], v0[1]); w.y = cvt_pk_bf16(v0[2], v0[3]); w.z = cvt_pk_bf16(v1[0], v1[1]); w.w = cvt_pk_bf16(v1[2], v1[3]);
                    *(u32x4*)(rowp + bj * HALF) = w;
                }
            }
    }
};

__device__ __forceinline__ void gemm_phase(LAS unsigned char* lds, const Gemm g, const StaticOrder& S, const Epi& E, const int tid) {
    const int wid = __builtin_amdgcn_readfirstlane(tid >> 6), lane = tid & 63, wr = wid >> 2, wc = wid & 3, fr = lane & 15, fq = lane >> 4;
    const int K = g.K, nt = K / BK, lda = g.lda;
    unsigned voffA[2], voffB[2];
#pragma unroll
    for (int i = 0; i < 2; ++i) { int R, C; stage_rc(tid * 16 + i * 8192, R, C); const int Rb = (R & ~31) + perm32(R & 31);
        voffA[i] = (unsigned)(R * lda + C) * 2u; voffB[i] = (unsigned)(Rb * K + C) * 2u; }
    const size_t kstep = (size_t)(BK * 2);
    const size_t hstepA = (size_t)HALF * lda * 2, hstepB = (size_t)HALF * K * 2;
    const size_t tstepA = 2 * hstepA, tstepB = 2 * hstepB;
    const unsigned ldsw = (unsigned)wid * 1024u;
    const int aoff = lds_byte(wr * 64 + fr, fq * 8), boff = lds_byte(wc * 32 + fr, fq * 8);
#define PG8_SA(b, h) (((b) * 2 + (h)) * HTB)
#define PG8_SB(b, h) ((4 + (b) * 2 + (h)) * HTB)
#define PG8_STAGE(bufoff, gbase, voff) do { _Pragma("unroll") for (int _i = 0; _i < 2; ++_i) \
        __builtin_amdgcn_global_load_lds((const unsigned*)((const char*)(gbase) + (voff)[_i]), (LAS unsigned*)(lds + (bufoff) + ldsw + _i * 8192), 16, 0, 0); } while (0)
#define PG8_LDA(dst, b, h) do { _Pragma("unroll") for (int m = 0; m < 4; ++m) _Pragma("unroll") for (int k = 0; k < 2; ++k) dst[m][k] = *(const LAS bf16x8*)(lds + PG8_SA(b, h) + aoff + m * 2048 + k * 1024); } while (0)
#define PG8_LDB(dst, b, h) do { _Pragma("unroll") for (int n = 0; n < 2; ++n) _Pragma("unroll") for (int k = 0; k < 2; ++k) dst[n][k] = *(const LAS bf16x8*)(lds + PG8_SB(b, h) + boff + n * 2048 + k * 1024); } while (0)
#define PG8_MMA(ai, bj, At, Bt) do { __builtin_amdgcn_s_setprio(1); _Pragma("unroll") for (int m = 0; m < 4; ++m) _Pragma("unroll") for (int n = 0; n < 2; ++n) _Pragma("unroll") for (int k = 0; k < 2; ++k) \
        acc[ai][bj][m][n] = __builtin_amdgcn_mfma_f32_16x16x32_bf16(Bt[n][k], At[m][k], acc[ai][bj][m][n], 0, 0, 0); __builtin_amdgcn_s_setprio(0); } while (0)
#define PG8_WAIT_V(n) asm volatile("s_waitcnt vmcnt(" #n ")" ::: "memory")
#define PG8_WAIT_L(n) asm volatile("s_waitcnt lgkmcnt(" #n ")" ::: "memory")
#define PG8_BAR __builtin_amdgcn_s_barrier()
#define PG8_SCHED __builtin_amdgcn_sched_barrier(0)
    Unit cur, nxt; int ui = 0;
    if (!S.next(0, cur)) return;
    f32x4 acc[2][2][4][2];
#pragma unroll
    for (int a = 0; a < 2; ++a)
#pragma unroll
        for (int b = 0; b < 2; ++b)
#pragma unroll
            for (int m = 0; m < 4; ++m)
#pragma unroll
                for (int n = 0; n < 2; ++n) acc[a][b][m][n] = (f32x4){0.f, 0.f, 0.f, 0.f};
    bf16x8 At[4][2], B0[2][2], B1[2][2];
    const char* cA = (const char*)g.A + (size_t)cur.pm * tstepA; const char* cB = (const char*)g.Bt + (size_t)cur.pn * tstepB;
    PG8_STAGE(PG8_SB(0, 0), cB, voffB); PG8_STAGE(PG8_SB(0, 1), cB + hstepB, voffB); PG8_STAGE(PG8_SA(0, 0), cA, voffA); PG8_STAGE(PG8_SA(0, 1), cA + hstepA, voffA);
    if (wr == 1) PG8_BAR;
    PG8_WAIT_V(2); PG8_BAR;
    PG8_STAGE(PG8_SB(1, 0), cB + kstep, voffB); PG8_STAGE(PG8_SA(1, 0), cA + kstep, voffA); PG8_STAGE(PG8_SB(1, 1), cB + hstepB + kstep, voffB);
    PG8_WAIT_V(6); PG8_BAR;
    for (;;) {
        const bool has_next = S.next(ui + 1, nxt);
        const char* nA = has_next ? (const char*)g.A + (size_t)nxt.pm * tstepA : cA; const char* nB = has_next ? (const char*)g.Bt + (size_t)nxt.pn * tstepB : cB;
        for (int t = 0; t < nt; t += 2) {
            const bool last = (t == nt - 2);
            const char* a1 = cA + (size_t)(t + 1) * kstep;
            const char* a2 = last ? nA : cA + (size_t)(t + 2) * kstep; const char* b2 = last ? nB : cB + (size_t)(t + 2) * kstep;
            const char* a3 = a2 + kstep; const char* b3 = b2 + kstep;
            PG8_LDB(B0, 0, 0); PG8_LDB(B1, 0, 1); PG8_SCHED; PG8_LDA(At, 0, 0); PG8_STAGE(PG8_SA(1, 1), a1 + hstepA, voffA);
            PG8_WAIT_V(8); PG8_WAIT_L(0); PG8_BAR; PG8_MMA(0, 0, At, B0); PG8_MMA(0, 1, At, B1); PG8_BAR; PG8_SCHED;
            PG8_LDA(At, 0, 1); PG8_STAGE(PG8_SB(0, 0), b2, voffB); PG8_STAGE(PG8_SB(0, 1), b2 + hstepB, voffB); PG8_STAGE(PG8_SA(0, 0), a2, voffA);
            PG8_WAIT_V(8); PG8_WAIT_L(0); PG8_BAR; PG8_MMA(1, 0, At, B0); PG8_MMA(1, 1, At, B1); PG8_BAR; PG8_SCHED;
            PG8_LDB(B0, 1, 0); PG8_LDB(B1, 1, 1); PG8_SCHED; PG8_LDA(At, 1, 0); PG8_STAGE(PG8_SA(0, 1), a2 + hstepA, voffA);
            PG8_WAIT_V(8); PG8_WAIT_L(0); PG8_BAR; PG8_MMA(0, 0, At, B0); PG8_MMA(0, 1, At, B1); PG8_BAR; PG8_SCHED;
            PG8_LDA(At, 1, 1); PG8_STAGE(PG8_SB(1, 0), b3, voffB); PG8_STAGE(PG8_SB(1, 1), b3 + hstepB, voffB); PG8_STAGE(PG8_SA(1, 0), a3, voffA);
            PG8_WAIT_V(8); PG8_WAIT_L(0); PG8_BAR; PG8_MMA(1, 0, At, B0); PG8_MMA(1, 1, At, B1); PG8_BAR; PG8_SCHED;
        }
        if (wr == 0) PG8_BAR;
        E(acc, cur, wr, wc, fr, fq);
        if (!has_next) break;
#pragma unroll
        for (int a = 0; a < 2; ++a)
#pragma unroll
            for (int b = 0; b < 2; ++b)
#pragma unroll
                for (int m = 0; m < 4; ++m)
#pragma unroll
                    for (int n = 0; n < 2; ++n) acc[a][b][m][n] = (f32x4){0.f, 0.f, 0.f, 0.f};
        cur = nxt; cA = nA; cB = nB; ++ui;
        if (wr == 1) PG8_BAR;
    }
    PG8_WAIT_V(0);
    PG8_BAR;
#undef PG8_SA
#undef PG8_SB
#undef PG8_STAGE
#undef PG8_LDA
#undef PG8_LDB
#undef PG8_MMA
#undef PG8_WAIT_V
#undef PG8_WAIT_L
#undef PG8_BAR
#undef PG8_SCHED
}
}

namespace att {
constexpr int PITCH = INC;
constexpr int LDS_K = 0, LDS_V = 8192, LDS_FLAG = 16384, LDS_OST = 32768;
__device__ __forceinline__ int crow(int r, int hi) { return (r & 3) + 8 * (r >> 2) + 4 * hi; }
#define SBAR() __builtin_amdgcn_sched_barrier(0)
__device__ __forceinline__ void pv(f32x16* o, int vb, bf16x8 pa0, bf16x8 pa1, bf16x8 pa2, bf16x8 pa3) {
#pragma unroll
    for (int d0 = 0; d0 < 2; ++d0) { s16x4 lo[4], hi[4];
#pragma unroll
        for (int ks = 0; ks < 4; ++ks) {
            asm volatile("ds_read_b64_tr_b16 %0,%1 offset:%c2" : "=&v"(lo[ks]) : "v"(vb), "i"(d0 * 4096 + ks * 1024) : "memory");
            asm volatile("ds_read_b64_tr_b16 %0,%1 offset:%c2" : "=&v"(hi[ks]) : "v"(vb), "i"(d0 * 4096 + ks * 1024 + 512) : "memory"); }
        asm volatile("s_waitcnt lgkmcnt(0)" ::: "memory"); SBAR();
#define PK(k) (bf16x8){lo[k][0], lo[k][1], lo[k][2], lo[k][3], hi[k][0], hi[k][1], hi[k][2], hi[k][3]}
        o[d0] = __builtin_amdgcn_mfma_f32_32x32x16_bf16(pa0, PK(0), o[d0], 0, 0, 0);
        o[d0] = __builtin_amdgcn_mfma_f32_32x32x16_bf16(pa1, PK(1), o[d0], 0, 0, 0);
        o[d0] = __builtin_amdgcn_mfma_f32_32x32x16_bf16(pa2, PK(2), o[d0], 0, 0, 0);
        o[d0] = __builtin_amdgcn_mfma_f32_32x32x16_bf16(pa3, PK(3), o[d0], 0, 0, 0);
#undef PK
    }
}
__device__ __forceinline__ float bcast_lo(float v) {
    auto rr = __builtin_amdgcn_permlane32_swap(__builtin_bit_cast(unsigned, v), __builtin_bit_cast(unsigned, v), false, false);
    return __builtin_bit_cast(float, rr[0]);
}
__device__ __forceinline__ void score_block(const LAS unsigned char* Ks, int blk, const bf16x8 (&qr)[4], const half8 (&tri)[2], int r32, int hi, int jbase, int t, float& carry, bf16x8& pa_lo, bf16x8& pa_hi) {
    f32x16 z;
#pragma unroll
    for (int r = 0; r < 16; ++r) z[r] = 0.f;
#pragma unroll
    for (int d0 = 0; d0 < 4; ++d0) {
        const bf16x8 kf = *(const LAS bf16x8*)(Ks + (2 * d0 + hi) * 1024 + (blk * 32 + r32) * 16);
        z = __builtin_amdgcn_mfma_f32_32x32x16_bf16(kf, qr[d0], z, 0, 0, 0);
    }
    float L[16], lsg[16];
#pragma unroll
    for (int r = 0; r < 16; ++r) {
        const int j = jbase + crow(r, hi);
        const bool valid = j < t;
        const float zz = z[r];
        const float e = __builtin_amdgcn_exp2f(-fabsf(zz));
        const float sp = fmaxf(zz, 0.f) + __builtin_amdgcn_logf(1.0f + e);
        L[r] = valid ? -sp : 0.f;
        lsg[r] = valid ? (zz - sp) : -INFINITY;
    }
    half8 lf0, lf1;
#pragma unroll
    for (int e = 0; e < 8; ++e) { lf0[e] = (_Float16)L[e]; lf1[e] = (_Float16)L[8 + e]; }
    f32x16 y;
#pragma unroll
    for (int r = 0; r < 16; ++r) y[r] = carry;
    y = __builtin_amdgcn_mfma_f32_32x32x16_f16(tri[0], lf0, y, 0, 0, 0);
    y = __builtin_amdgcn_mfma_f32_32x32x16_f16(tri[1], lf1, y, 0, 0, 0);
    float a[16];
#pragma unroll
    for (int r = 0; r < 16; ++r) a[r] = __builtin_amdgcn_exp2f(lsg[r] + y[r]);
    carry = bcast_lo(y[0] + L[0]);
    u32x4 w0, w1;
    w0.x = cvt_pk_bf16(a[0], a[1]); w0.y = cvt_pk_bf16(a[2], a[3]); w0.z = cvt_pk_bf16(a[4], a[5]); w0.w = cvt_pk_bf16(a[6], a[7]);
    w1.x = cvt_pk_bf16(a[8], a[9]); w1.y = cvt_pk_bf16(a[10], a[11]); w1.z = cvt_pk_bf16(a[12], a[13]); w1.w = cvt_pk_bf16(a[14], a[15]);
    pa_lo = __builtin_bit_cast(bf16x8, w0); pa_hi = __builtin_bit_cast(bf16x8, w1);
}

__device__ __forceinline__ void attn_unit(int b, int h, int qb, bf16_t* PROJ, LAS unsigned char* lds, const int tid) {
    const int lane = tid & 63, r32 = lane & 31, hi = lane >> 5; const int wid = __builtin_amdgcn_readfirstlane(tid >> 6);
    const long rowbase = (long)b * SEQ; const int q0 = qb * 256; const int qw0 = q0 + wid * 32;
    bf16_t* Qw = PROJ + (rowbase + qw0) * PITCH + 1536 + h * 64;
    const bf16_t* Kh = PROJ + rowbase * PITCH + 2048 + h * 64; const bf16_t* Vh = PROJ + rowbase * PITCH + 2560 + h * 64;
    bf16x8 qr[4];
#pragma unroll
    for (int d0 = 0; d0 < 4; ++d0) qr[d0] = *(const bf16x8*)(Qw + (long)r32 * PITCH + d0 * 16 + hi * 8);
    half8 tri[2];
#pragma unroll
    for (int s = 0; s < 2; ++s)
#pragma unroll
        for (int e = 0; e < 8; ++e) { const int kk = 16 * s + 8 * (e >> 2) + 4 * hi + (e & 3); tri[s][e] = (kk > r32) ? (_Float16)1.0f : (_Float16)0.0f; }
    f32x16 o[2];
#pragma unroll
    for (int r = 0; r < 16; ++r) { o[0][r] = 0.f; o[1][r] = 0.f; }
    float carry = 0.f;
    const int t = qw0 + r32;
    const int skey = tid >> 3, sc8 = tid & 7;
    const bf16_t* kg = Kh + (long)skey * PITCH + sc8 * 8; const bf16_t* vg = Vh + (long)skey * PITCH + sc8 * 8;
    LAS unsigned char* kdst = lds + LDS_K + sc8 * 1024 + skey * 16;
    LAS unsigned char* vdst = lds + LDS_V + ((sc8 >> 2) * 4 + (skey >> 4)) * 1024 + (skey & 15) * 64 + (sc8 & 3) * 16;
    volatile LAS unsigned* flags = (volatile LAS unsigned*)(lds + LDS_FLAG);
    const int vb = (int)(unsigned)(uintptr_t)(lds + LDS_V) + ((lane >> 4) & 1) * 32 + (lane & 3) * 8 + (4 * hi + ((lane & 15) >> 2)) * 64;
    int kt = 4 * qb + 3;
    u32x4 kreg = *(const u32x4*)(kg + (long)kt * 64 * PITCH), vreg = *(const u32x4*)(vg + (long)kt * 64 * PITCH);
    bool wdone = false;
    if (lane == 0) flags[wid] = 0u;
    for (;;) {
        __syncthreads();
        unsigned alld = 1u;
#pragma unroll
        for (int w = 0; w < 8; ++w) alld &= flags[w];
        if (alld) break;
        *(LAS u32x4*)kdst = kreg; *(LAS u32x4*)vdst = vreg;
        __syncthreads();
        if (kt > 0) { kreg = *(const u32x4*)(kg + (long)(kt - 1) * 64 * PITCH); vreg = *(const u32x4*)(vg + (long)(kt - 1) * 64 * PITCH); }
        const int kbase = kt * 64;
        if (!wdone && kbase < qw0 + 31) {
            bf16x8 pa0, pa1, pa2, pa3;
            const u32x4 zz = (u32x4){0u, 0u, 0u, 0u};
            pa0 = pa1 = pa2 = pa3 = __builtin_bit_cast(bf16x8, zz);
            if (kbase + 32 < qw0 + 31) score_block(lds + LDS_K, 1, qr, tri, r32, hi, kbase + 32, t, carry, pa2, pa3);
            score_block(lds + LDS_K, 0, qr, tri, r32, hi, kbase, t, carry, pa0, pa1);
            pv(o, vb, pa0, pa1, pa2, pa3);
            wdone = __all(carry < EXIT_THR);
        }
        if (kt == 0) wdone = true;
        if (lane == 0) flags[wid] = wdone ? 1u : 0u;
        --kt;
    }
    {
        LAS bf16_t* stg = (LAS bf16_t*)(lds + LDS_OST) + wid * 2048;
#pragma unroll
        for (int r = 0; r < 16; ++r) { const int orow = crow(r, hi);
#pragma unroll
            for (int d0 = 0; d0 < 2; ++d0) stg[orow * 64 + d0 * 32 + r32] = (bf16_t)(cvt_pk_bf16(o[d0][r], 0.f) & 0xffffu); }
        asm volatile("s_waitcnt lgkmcnt(0)" ::: "memory");
#pragma unroll
        for (int i = 0; i < 4; ++i) { const int row = i * 8 + (lane >> 3), ch = lane & 7; const u32x4 v = *(const LAS u32x4*)(stg + row * 64 + ch * 8); *(u32x4*)(Qw + (long)row * PITCH + ch * 8) = v; }
    }
    __syncthreads();
}
#undef SBAR
}

enum { T_MOD = 0, T_TRANS = 1, T_ROW = 2, T_GEMM = 3, T_ATTN = 4 };
struct PhaseDesc { const void* p[8]; int type, sync, i0, i1, i2, i3, i4, i5; };
constexpr int N_PHASES = 21;
struct Args { PhaseDesc ph[N_PHASES]; int ph_lo, ph_hi; };

__device__ __forceinline__ float wave_sum(float v) {
#pragma unroll
    for (int o = 1; o < 64; o <<= 1) v += __shfl_xor(v, o);
    return v;
}
__device__ __forceinline__ unsigned f2bf(float f) { unsigned u = __builtin_bit_cast(unsigned, f); return (u + 0x7fffu + ((u >> 16) & 1u)) >> 16; }
__device__ __forceinline__ unsigned pk2(float lo, float hi) { return f2bf(lo) | (f2bf(hi) << 16); }

__device__ __forceinline__ void transpose_item(const float* W, int K, int N, bf16_t* WT, LAS float* scr, int item, int lane) {
    const int nblk = N / 32, kb = item / nblk, nb = item % nblk, k0 = 64 * kb, n0 = 32 * nb;
#pragma unroll 8
    for (int i = 0; i < 32; ++i) { const int kk = 2 * i + (lane >> 5); scr[kk * 33 + (lane & 31)] = W[(size_t)(k0 + kk) * N + n0 + (lane & 31)]; }
    asm volatile("s_waitcnt lgkmcnt(0)" ::: "memory");
    const int c = lane & 7;
#pragma unroll
    for (int j = 0; j < 4; ++j) { const int n = (lane >> 3) + 8 * j; const LAS float* s = scr + (8 * c) * 33 + n;
        u32x4 o; o.x = pk2(s[0 * 33], s[1 * 33]); o.y = pk2(s[2 * 33], s[3 * 33]); o.z = pk2(s[4 * 33], s[5 * 33]); o.w = pk2(s[6 * 33], s[7 * 33]);
        *(u32x4*)(WT + (size_t)(n0 + n) * K + k0 + 8 * c) = o; }
    asm volatile("s_waitcnt lgkmcnt(0)" ::: "memory");
}

__device__ __forceinline__ void row_phase(int gw, int ngw, int lane, bool has_src, bool has_next, const bf16_t* src, const float* xin, float* xout,
                                          const float* g_post, const float* gate  , const float* g_pre, const float* shift, const float* scale, bf16_t* xn) {
    for (int m = gw; m < MT; m += ngw) {
        const int b = m >> 13;
        f32x4 x[4];
#pragma unroll
        for (int j = 0; j < 4; ++j) x[j] = *(const f32x4*)(xin + (size_t)m * DM + 4 * lane + 256 * j);
        if (has_src) {
            f32x4 s[4]; float ss = 0.f;
#pragma unroll
            for (int j = 0; j < 4; ++j) { const u32x2 w = *(const u32x2*)(src + (size_t)m * DM + 4 * lane + 256 * j);
                s[j] = (f32x4){bf_lo(w.x), bf_hi(w.x), bf_lo(w.y), bf_hi(w.y)}; ss += (s[j].x * s[j].x + s[j].y * s[j].y) + (s[j].z * s[j].z + s[j].w * s[j].w); }
            const float rstd = __builtin_amdgcn_rsqf(wave_sum(ss) * (1.0f / DM) + EPS);
#pragma unroll
            for (int j = 0; j < 4; ++j) { const f32x4 gp = *(const f32x4*)(g_post + 4 * lane + 256 * j); const f32x4 gt = *(const f32x4*)(gate + (size_t)b * (NMOD * DM) + 4 * lane + 256 * j);
                x[j] = x[j] + gt * (s[j] * rstd * gp);
                *(f32x4*)(xout + (size_t)m * DM + 4 * lane + 256 * j) = x[j]; }
        }
        if (has_next) {
            float ss = 0.f;
#pragma unroll
            for (int j = 0; j < 4; ++j) ss += (x[j].x * x[j].x + x[j].y * x[j].y) + (x[j].z * x[j].z + x[j].w * x[j].w);
            const float rstd = __builtin_amdgcn_rsqf(wave_sum(ss) * (1.0f / DM) + EPS);
#pragma unroll
            for (int j = 0; j < 4; ++j) { const f32x4 gp = *(const f32x4*)(g_pre + 4 * lane + 256 * j);
                const f32x4 sh = *(const f32x4*)(shift + (size_t)b * (NMOD * DM) + 4 * lane + 256 * j), sc = *(const f32x4*)(scale + (size_t)b * (NMOD * DM) + 4 * lane + 256 * j);
                const f32x4 hh = (x[j] * rstd * gp) * (sc + 1.0f) + sh;
                u32x2 w; w.x = cvt_pk_bf16(hh.x, hh.y); w.y = cvt_pk_bf16(hh.z, hh.w);
                *(u32x2*)(xn + (size_t)m * DM + 4 * lane + 256 * j) = w; }
        }
    }
}


constexpr int LDS_TOTAL = 131072 + 1024;

__global__ void __launch_bounds__(512, 2) mega_fwd(Args args) {
    __shared__ __attribute__((aligned(16))) unsigned char lds_raw[LDS_TOTAL];
    LAS unsigned char* lds = (LAS unsigned char*)lds_raw;
    for (int ph = args.ph_lo; ph < args.ph_hi; ++ph) {
        int tid = threadIdx.x; asm volatile("" : "+v"(tid));
        const int lane = tid & 63; const int wave = __builtin_amdgcn_readfirstlane(tid >> 6);
        const int G = gridDim.x, bx = blockIdx.x;
        const int gw = bx * 8 + wave, ngw = G * 8;
        const PhaseDesc& d = args.ph[ph];
        const int type = d.type;
        if (type == T_GEMM) {
            pg8::Gemm g{(const bf16_t*)d.p[0], (const bf16_t*)d.p[1], MT, d.i0, d.i1, d.i2};
            pg8::Epi E{(bf16_t*)d.p[2], d.i3, d.i4, (const bf16_t*)d.p[3], d.i5};
            pg8::StaticOrder S; S.init(MT, g.N, G, bx);
            pg8::gemm_phase(lds, g, S, E, tid);
        } else if (type == T_ATTN) {
            bf16_t* PROJ = (bf16_t*)d.p[0];
            for (int u = bx; u < 16 * 32; u += G) { const int bh = u >> 5, qb = u & 31; att::attn_unit(bh >> 3, bh & 7, qb, PROJ, lds, tid); }
            const float* cw = (const float*)d.p[1];
            const int ch = lane * 8;
            float w0[8], w1[8], w2[8];
#pragma unroll
            for (int i = 0; i < 8; ++i) { w0[i] = cw[ch + i]; w1[i] = cw[CWID + ch + i]; w2[i] = cw[2 * CWID + ch + i]; }
            for (int chunk = gw; chunk < MT / 8; chunk += ngw) {
                const int m0 = chunk * 8; const int tpos = m0 & (SEQ - 1);
                float v2[8], v1[8];
#pragma unroll
                for (int i = 0; i < 8; ++i) { v2[i] = 0.f; v1[i] = 0.f; }
                if (tpos >= 2) {
                    const u32x4 c2 = *(const u32x4*)(PROJ + (size_t)(m0 - 2) * INC + 512 + ch), u2 = *(const u32x4*)(PROJ + (size_t)(m0 - 2) * INC + 1024 + ch);
                    const u32x4 c1 = *(const u32x4*)(PROJ + (size_t)(m0 - 1) * INC + 512 + ch), u1 = *(const u32x4*)(PROJ + (size_t)(m0 - 1) * INC + 1024 + ch);
#pragma unroll
                    for (int i = 0; i < 4; ++i) { v2[2 * i] = bf_lo(c2[i]) * bf_lo(u2[i]); v2[2 * i + 1] = bf_hi(c2[i]) * bf_hi(u2[i]); v1[2 * i] = bf_lo(c1[i]) * bf_lo(u1[i]); v1[2 * i + 1] = bf_hi(c1[i]) * bf_hi(u1[i]); }
                }
                for (int i8 = 0; i8 < 8; ++i8) {
                    const size_t m = (size_t)(m0 + i8);
                    const u32x4 cc = *(const u32x4*)(PROJ + m * INC + 512 + ch), uu = *(const u32x4*)(PROJ + m * INC + 1024 + ch), bb = *(const u32x4*)(PROJ + m * INC + ch);
                    float v0[8], y[8];
#pragma unroll
                    for (int i = 0; i < 4; ++i) { v0[2 * i] = bf_lo(cc[i]) * bf_lo(uu[i]); v0[2 * i + 1] = bf_hi(cc[i]) * bf_hi(uu[i]); }
#pragma unroll
                    for (int i = 0; i < 8; ++i) y[i] = w0[i] * v2[i] + w1[i] * v1[i] + w2[i] * v0[i];
                    u32x4 o;
#pragma unroll
                    for (int i = 0; i < 4; ++i) o[i] = cvt_pk_bf16(bf_lo(bb[i]) * y[2 * i], bf_hi(bb[i]) * y[2 * i + 1]);
                    *(u32x4*)(PROJ + m * INC + ch) = o;
#pragma unroll
                    for (int i = 0; i < 8; ++i) { v2[i] = v1[i]; v1[i] = v0[i]; }
                }
            }
        } else if (type == T_ROW) {
            row_phase(gw, ngw, lane, d.i0 != 0, d.i1 != 0, (const bf16_t*)d.p[0], (const float*)d.p[1], (float*)d.p[2], (const float*)d.p[3], (const float*)d.p[4],
                      (const float*)d.p[5], (const float*)d.p[6], (const float*)d.p[6] + DM, (bf16_t*)d.p[7]);
        } else if (type == T_MOD) {
            const float* w_ada = (const float*)d.p[0]; const float* b_ada = (const float*)d.p[1]; float* MOD = (float*)d.p[2]; const float* cvec = (const float*)d.p[3];
            for (int it = bx; it < 96; it += G) {
                const int l = it / 48, n0 = (it % 48) * 128, n = n0 + 2 * lane;
                f32x2 a0 = (f32x2){0.f, 0.f}, a1 = (f32x2){0.f, 0.f};
                const float* wp = w_ada + ((size_t)l * DM + wave * 128) * (NMOD * DM) + n;
                const float* c0p = cvec + wave * 128; const float* c1p = cvec + DM + wave * 128;
#pragma unroll 8
                for (int k = 0; k < 128; ++k) { const f32x2 wv = *(const f32x2*)(wp + (size_t)k * (NMOD * DM)); const float c0 = c0p[k], c1 = c1p[k]; a0 += wv * c0; a1 += wv * c1; }
                LAS float* red = (LAS float*)lds;
                red[(wave * 2 + 0) * 128 + 2 * lane] = a0.x; red[(wave * 2 + 0) * 128 + 2 * lane + 1] = a0.y;
                red[(wave * 2 + 1) * 128 + 2 * lane] = a1.x; red[(wave * 2 + 1) * 128 + 2 * lane + 1] = a1.y;
                __syncthreads();
                if (tid < 256) { const int b = tid >> 7, col = tid & 127; float s = b_ada[(size_t)l * (NMOD * DM) + n0 + col];
#pragma unroll
                    for (int w = 0; w < 8; ++w) s += red[(w * 2 + b) * 128 + col];
                    MOD[((size_t)l * 2 + b) * (NMOD * DM) + n0 + col] = s; }
                __syncthreads();
            }
        } else {
            LAS float* scr = (LAS float*)(lds + wave * 16384);
            constexpr int I_IN = (DM / 64) * (INC / 32), I_PC = (CWID / 64) * (DM / 32), I_OUT = (DM / 64) * (DM / 32), I_W1 = (DM / 64) * (FF / 32), I_W2 = (FF / 64) * (DM / 32);
            constexpr int I_L = I_IN + 2 * I_PC + I_OUT + I_W1 + I_W2;
            unsigned char* wbase = (unsigned char*)d.p[6];
            for (int it = gw; it < 2 * I_L; it += ngw) {
                const int l = it / I_L; int r = it % I_L;
                unsigned char* wl = wbase + (size_t)l * WL_SZ;
                if (r < I_IN) { transpose_item((const float*)d.p[0] + (size_t)l * DM * INC, DM, INC, (bf16_t*)(wl + WL_IN), scr, r, lane); continue; } r -= I_IN;
                if (r < I_PC) { transpose_item((const float*)d.p[1] + (size_t)l * CWID * DM, CWID, DM, (bf16_t*)(wl + WL_PC), scr, r, lane); continue; } r -= I_PC;
                if (r < I_PC) { transpose_item((const float*)d.p[2] + (size_t)l * CWID * DM, CWID, DM, (bf16_t*)(wl + WL_PA), scr, r, lane); continue; } r -= I_PC;
                if (r < I_OUT) { transpose_item((const float*)d.p[3] + (size_t)l * DM * DM, DM, DM, (bf16_t*)(wl + WL_OUT), scr, r, lane); continue; } r -= I_OUT;
                if (r < I_W1) { transpose_item((const float*)d.p[4] + (size_t)l * DM * FF, DM, FF, (bf16_t*)(wl + WL_W1), scr, r, lane); continue; } r -= I_W1;
                transpose_item((const float*)d.p[5] + (size_t)l * FF * DM, FF, DM, (bf16_t*)(wl + WL_W2), scr, r, lane);
            }
        }
        if (d.sync && ph + 1 < args.ph_hi) cg::this_grid().sync();
    }
}

static void build_phases(Args& a, void* const* d_in, void* d_out, void* d_ws) {
    unsigned char* ws = (unsigned char*)d_ws;
    float* MOD = (float*)(ws + WS_MOD); bf16_t* XN = (bf16_t*)(ws + WS_XN); bf16_t* PROJ = (bf16_t*)(ws + WS_PROJ);
    const float* x_in = (const float*)d_in[0];
    const float* g_pre_mix = (const float*)d_in[4]; const float* g_post_mix = (const float*)d_in[5]; const float* g_pre_mlp = (const float*)d_in[6]; const float* g_post_mlp = (const float*)d_in[7];
    float* out = (float*)d_out;
    int n = 0;
    auto add = [&](int type, int sync) -> PhaseDesc& { PhaseDesc& d = a.ph[n++]; d.type = type; d.sync = sync; return d; };
    { PhaseDesc& d = add(T_MOD, 0); d.p[0] = d_in[2]; d.p[1] = d_in[3]; d.p[2] = MOD; d.p[3] = d_in[1]; }
    { PhaseDesc& d = add(T_TRANS, 1); d.p[0] = d_in[8]; d.p[1] = d_in[10]; d.p[2] = d_in[11]; d.p[3] = d_in[12]; d.p[4] = d_in[13]; d.p[5] = d_in[14]; d.p[6] = ws + WS_W; }
    { PhaseDesc& d = add(T_ROW, 1); d.i0 = 0; d.i1 = 1; d.p[0] = XN; d.p[1] = x_in; d.p[2] = out; d.p[3] = g_pre_mix; d.p[4] = MOD; d.p[5] = g_pre_mix; d.p[6] = MOD + 0 * DM; d.p[7] = XN; }
    for (int l = 0; l < 2; ++l) {
        const unsigned char* wl = ws + WS_W + (size_t)l * WL_SZ;
        const float* modl = MOD + (size_t)l * 2 * (NMOD * DM);
        auto gemm = [&](const bf16_t* A, const void* Bt, int N, int K, int lda, bf16_t* O, int ldc, int mode, const bf16_t* Gt, int ldg, int sync) {
            PhaseDesc& d = add(T_GEMM, sync); d.p[0] = A; d.p[1] = Bt; d.p[2] = O; d.p[3] = Gt ? Gt : O; d.i0 = N; d.i1 = K; d.i2 = lda; d.i3 = ldc; d.i4 = mode; d.i5 = ldg; };
        gemm(XN, wl + WL_IN, INC, DM, DM, PROJ, INC, 1, nullptr, 0, 1);
        { PhaseDesc& d = add(T_ATTN, 1); d.p[0] = PROJ; d.p[1] = (const float*)d_in[9] + (size_t)l * 3 * CWID; }
        gemm(PROJ, wl + WL_PC, DM, CWID, INC, XN, DM, 3, PROJ + 3072, INC, 0);
        gemm(PROJ + 1536, wl + WL_PA, DM, CWID, INC, XN, DM, 4, PROJ + 4096, INC, 1);
        gemm(XN, wl + WL_OUT, DM, DM, DM, PROJ, DM, 0, nullptr, 0, 1);
        { PhaseDesc& d = add(T_ROW, 1); d.i0 = 1; d.i1 = 1; d.p[0] = PROJ; d.p[1] = (l == 0) ? x_in : out; d.p[2] = out; d.p[3] = g_post_mix + (size_t)l * DM; d.p[4] = modl + 2 * DM;
          d.p[5] = g_pre_mlp + (size_t)l * DM; d.p[6] = modl + 3 * DM; d.p[7] = XN; }
        gemm(XN, wl + WL_W1, FF, DM, DM, PROJ, FF, 2, nullptr, 0, 1);
        gemm(PROJ, wl + WL_W2, DM, FF, FF, XN, DM, 0, nullptr, 0, 1);
        { const int ln = (l + 1 < 2) ? l + 1 : l; const float* modn = MOD + (size_t)ln * 2 * (NMOD * DM);
          PhaseDesc& d = add(T_ROW, 1); d.i0 = 1; d.i1 = (l == 0) ? 1 : 0; d.p[0] = XN; d.p[1] = out; d.p[2] = out; d.p[3] = g_post_mlp + (size_t)l * DM; d.p[4] = modl + 5 * DM;
          d.p[5] = g_pre_mix + (size_t)ln * DM; d.p[6] = modn + 0 * DM; d.p[7] = XN; }
    }
    if (n != N_PHASES) fprintf(stderr, "phase count mismatch: %d vs %d\n", n, N_PHASES);
}

extern "C" void kernel_launch(void* const* d_in, const int* in_sizes, int n_in, void* d_out, int out_size, void* d_ws, size_t ws_size, hipStream_t stream) {
    static int grid = 0;
    if (grid == 0) {
        int dev = 0, cus = 0, per_cu = 0;
        (void)hipGetDevice(&dev);
        (void)hipDeviceGetAttribute(&cus, hipDeviceAttributeMultiprocessorCount, dev);
        if (hipOccupancyMaxActiveBlocksPerMultiprocessor(&per_cu, (const void*)mega_fwd, 512, 0) != hipSuccess || per_cu < 1) per_cu = 1;
        (void)hipGetLastError();
        if (per_cu > 1) per_cu = 1;
        grid = cus * per_cu;
        if (ws_size < WS_END) fprintf(stderr, "kernel_launch: workspace too small: %zu < %zu\n", ws_size, (size_t)WS_END);
    }
    Args a{};
    build_phases(a, d_in, d_out, d_ws);
#if MULTI_LAUNCH
    for (int ph = 0; ph < N_PHASES;) { int e = ph; while (!a.ph[e].sync) ++e; a.ph_lo = ph; a.ph_hi = e + 1; hipLaunchKernelGGL(mega_fwd, dim3(grid), dim3(512), 0, stream, a); ph = e + 1; }
#else
    a.ph_lo = 0; a.ph_hi = N_PHASES;
    void* kargs[] = {&a};
    hipError_t e = hipLaunchCooperativeKernel((const void*)mega_fwd, dim3(grid), dim3(512), kargs, 0, stream);
    if (e != hipSuccess) fprintf(stderr, "cooperative launch failed: %s (grid %d)\n", hipGetErrorString(e), grid);
#endif
}
```

```cpp
#include <hip/hip_runtime.h>
#include <hip/hip_cooperative_groups.h>
#include <cstdio>
#include <cstdint>
namespace cg = cooperative_groups;

#ifndef MULTI_LAUNCH
#define MULTI_LAUNCH 0
#endif
#ifndef PROBE_TIMING
#define PROBE_TIMING 0
#endif
#ifndef PROBE_MASK
#define PROBE_MASK 0
#endif

#define LAS __attribute__((address_space(3)))
typedef unsigned short bf16_t;
typedef short bf16x8 __attribute__((ext_vector_type(8)));
typedef _Float16 half8 __attribute__((ext_vector_type(8)));
typedef float f32x4 __attribute__((ext_vector_type(4)));
typedef float f32x2 __attribute__((ext_vector_type(2)));
typedef float f32x16 __attribute__((ext_vector_type(16)));
typedef unsigned u32x4 __attribute__((ext_vector_type(4)));
typedef unsigned u32x2 __attribute__((ext_vector_type(2)));
typedef short s16x4 __attribute__((ext_vector_type(4)));

constexpr int DM = 1024, SEQ = 8192, NB = 2, MT = NB * SEQ, INC = 5120, CWID = 512, FF = 4096, NMOD = 6;
constexpr float EPS = 1e-6f;
constexpr float LOG2E = 1.4426950408889634f;
constexpr float QSCALE = 0.125f * LOG2E;
constexpr float EXIT_THR = -150.0f;

constexpr size_t MiB = 1u << 20;
constexpr size_t WS_MOD = 0;
constexpr size_t WS_BAR = 1 * MiB;
constexpr size_t WS_W = 2 * MiB;
constexpr size_t WL_IN = 0, WL_PC = 10 * MiB, WL_PA = 11 * MiB, WL_OUT = 12 * MiB, WL_W1 = 14 * MiB, WL_W2 = 22 * MiB, WL_SZ = 30 * MiB;
constexpr size_t WS_XN = 62 * MiB;
constexpr size_t WS_PROJ = 94 * MiB;
constexpr size_t WS_END = 254 * MiB;

typedef __bf16 bf16x2_t __attribute__((ext_vector_type(2)));
__device__ __forceinline__ unsigned cvt_pk_bf16(float lo, float hi) { f32x2 v = {lo, hi}; bf16x2_t b = __builtin_convertvector(v, bf16x2_t); return __builtin_bit_cast(unsigned, b); }
__device__ __forceinline__ float bf_lo(unsigned w) { return __builtin_bit_cast(float, w << 16); }
__device__ __forceinline__ float bf_hi(unsigned w) { return __builtin_bit_cast(float, w & 0xffff0000u); }
__device__ __forceinline__ float fast_sigmoid(float v) { return __builtin_amdgcn_rcpf(1.0f + __builtin_amdgcn_exp2f(-v * LOG2E)); }

__device__ __forceinline__ void st_wt16(void* p, u32x4 v) { asm volatile("global_store_dwordx4 %0, %1, off sc1\n\ts_nop 1" :: "v"(p), "v"(v) : "memory"); }
__device__ __forceinline__ void st_wt16f(void* p, f32x4 v) { asm volatile("global_store_dwordx4 %0, %1, off sc1\n\ts_nop 1" :: "v"(p), "v"(v) : "memory"); }
__device__ __forceinline__ void st_wt8(void* p, u32x2 v) { asm volatile("global_store_dwordx2 %0, %1, off sc1\n\ts_nop 1" :: "v"(p), "v"(v) : "memory"); }

namespace pg8 {
constexpr int BM = 256, BK = 64, HALF = 128, HTB = HALF * BK * 2, STAGE_BYTES = 8 * HTB, NXCD = 8, WGM = 4;
__host__ __device__ __forceinline__ int lds_byte(int r, int c) { const int st = (r >> 4) * 2 + (c >> 5), rr = r & 15, cc = c & 31, ob = rr * 64 + cc * 2; return st * 1024 + (ob ^ (((ob >> 9) & 1) << 5)); }
__host__ __device__ __forceinline__ void stage_rc(int b, int& R, int& C) { const int st = b / 1024, sb = b % 1024, swz = sb ^ (((sb >> 9) & 1) << 5); R = (st >> 1) * 16 + swz / 64; C = (st & 1) * 32 + (swz % 64) / 2; }
__host__ __device__ __forceinline__ int perm32(int rho) { const int n = rho >> 4, i = rho & 15; return 8 * (i >> 2) + 4 * n + (i & 3); }
struct Unit { int pm, pn; };
struct Gemm { const bf16_t* A; const bf16_t* Bt; int M, N, K, lda; int a2, b2; };
struct StaticOrder {
    int nM, nN, nwg, G, c;
    __device__ void init(int M, int N, int G_, int c_) { nM = M / BM; nN = N / BM; nwg = nM * nN; G = G_; c = c_; }
    __device__ bool next(int i, Unit& u) const {
        const long L = (long)i * G + c; if (L >= nwg) return false;
        int wgid = (int)L; { const int q = nwg / NXCD, r = nwg % NXCD, xcd = wgid % NXCD, off = wgid / NXCD; wgid = (xcd < r ? xcd * (q + 1) : r * (q + 1) + (xcd - r) * q) + off; }
        const int nig = WGM * nN, gid = wgid / nig, fm = gid * WGM, gsz = (nM - fm) < WGM ? (nM - fm) : WGM;
        u.pm = fm + ((wgid % nig) % gsz); u.pn = (wgid % nig) / gsz; return true;
    }
};
constexpr float GB_TINY = 1e-30f;
struct Epi {
    bf16_t* O; int ldc; int mode; const bf16_t* Gt; int ldg;
    __device__ __forceinline__ void rescale(f32x4 (&acc)[2][2][4][2], const Unit& u, int wr, int wc, int fr, int fq) const {
        const int row0 = u.pm * BM + wr * 64 + fr; const int col0 = u.pn * BM + wc * 32 + 8 * fq;
#pragma unroll
        for (int ai = 0; ai < 2; ++ai) {
            u32x4 ga[4][2], gb[4][2];
#pragma unroll
            for (int m = 0; m < 4; ++m)
#pragma unroll
                for (int bj = 0; bj < 2; ++bj) { const bf16_t* gp = Gt + (size_t)(row0 + ai * HALF + m * 16) * ldg + col0 + bj * HALF; gb[m][bj] = *(const u32x4*)gp; ga[m][bj] = *(const u32x4*)(gp - 1024); }
            __builtin_amdgcn_sched_barrier(0);
#pragma unroll
            for (int m = 0; m < 4; ++m)
#pragma unroll
                for (int bj = 0; bj < 2; ++bj) { const u32x4 a = ga[m][bj], b = gb[m][bj];
#define PG8_RATIO(x, y) ((x) * __builtin_amdgcn_rcpf(fmaxf((y), GB_TINY)))
                    acc[ai][bj][m][0][0] *= PG8_RATIO(bf_lo(a.x), bf_lo(b.x)); acc[ai][bj][m][0][1] *= PG8_RATIO(bf_hi(a.x), bf_hi(b.x)); acc[ai][bj][m][0][2] *= PG8_RATIO(bf_lo(a.y), bf_lo(b.y)); acc[ai][bj][m][0][3] *= PG8_RATIO(bf_hi(a.y), bf_hi(b.y));
                    acc[ai][bj][m][1][0] *= PG8_RATIO(bf_lo(a.z), bf_lo(b.z)); acc[ai][bj][m][1][1] *= PG8_RATIO(bf_hi(a.z), bf_hi(b.z)); acc[ai][bj][m][1][2] *= PG8_RATIO(bf_lo(a.w), bf_lo(b.w)); acc[ai][bj][m][1][3] *= PG8_RATIO(bf_hi(a.w), bf_hi(b.w));
#undef PG8_RATIO
                }
        }
    }
    __device__ __forceinline__ void operator()(const f32x4 (&acc)[2][2][4][2], const Unit& u, int wr, int wc, int fr, int fq) const {
        const int row0 = u.pm * BM + wr * 64 + fr; const int col0 = u.pn * BM + wc * 32 + 8 * fq;
        int m1 = 0; float sc = 1.f;
        if (mode == 1) { if (u.pn >= 12) m1 = 1; else if (u.pn == 6 || u.pn == 7) sc = QSCALE; }
        if (mode == 6) {
#pragma unroll
            for (int ai = 0; ai < 2; ++ai) {
                u32x4 gv[4][2];
#pragma unroll
                for (int m = 0; m < 4; ++m)
#pragma unroll
                    for (int bj = 0; bj < 2; ++bj) gv[m][bj] = *(const u32x4*)(Gt + (size_t)(row0 + ai * HALF + m * 16) * ldg + col0 + bj * HALF);
                __builtin_amdgcn_sched_barrier(0);
#pragma unroll
                for (int m = 0; m < 4; ++m) {
                    bf16_t* rowp = O + (size_t)(row0 + ai * HALF + m * 16) * ldc + col0;
#pragma unroll
                    for (int bj = 0; bj < 2; ++bj) {
                        f32x4 v0 = acc[ai][bj][m][0], v1 = acc[ai][bj][m][1]; const u32x4 g = gv[m][bj];
                        v0[0] *= fmaxf(bf_lo(g.x), GB_TINY); v0[1] *= fmaxf(bf_hi(g.x), GB_TINY); v0[2] *= fmaxf(bf_lo(g.y), GB_TINY); v0[3] *= fmaxf(bf_hi(g.y), GB_TINY);
                        v1[0] *= fmaxf(bf_lo(g.z), GB_TINY); v1[1] *= fmaxf(bf_hi(g.z), GB_TINY); v1[2] *= fmaxf(bf_lo(g.w), GB_TINY); v1[3] *= fmaxf(bf_hi(g.w), GB_TINY);
                        u32x4 w; w.x = cvt_pk_bf16(v0[0], v0[1]); w.y = cvt_pk_bf16(v0[2], v0[3]); w.z = cvt_pk_bf16(v1[0], v1[1]); w.w = cvt_pk_bf16(v1[2], v1[3]);
                        st_wt16(rowp + bj * HALF, w);
                    }
                }
            }
            return;
        }
        if (mode >= 3) {
#pragma unroll
            for (int ai = 0; ai < 2; ++ai) {
                u32x4 gv[4][2], pv_[4][2];
#pragma unroll
                for (int m = 0; m < 4; ++m)
#pragma unroll
                    for (int bj = 0; bj < 2; ++bj) {
                        const size_t row = (size_t)(row0 + ai * HALF + m * 16);
                        gv[m][bj] = *(const u32x4*)(Gt + row * ldg + col0 + bj * HALF);
                        pv_[m][bj] = (mode == 4) ? *(const u32x4*)(O + row * ldc + col0 + bj * HALF) : (u32x4){0u, 0u, 0u, 0u};
                    }
                __builtin_amdgcn_sched_barrier(0);
#pragma unroll
                for (int m = 0; m < 4; ++m) {
                    const size_t row = (size_t)(row0 + ai * HALF + m * 16);
                    bf16_t* rowp = O + row * ldc + col0;
#pragma unroll
                    for (int bj = 0; bj < 2; ++bj) {
                        f32x4 v0 = acc[ai][bj][m][0], v1 = acc[ai][bj][m][1];
                        const u32x4 g = gv[m][bj], p = pv_[m][bj];
                        v0[0] = v0[0] * bf_lo(g.x) + bf_lo(p.x); v0[1] = v0[1] * bf_hi(g.x) + bf_hi(p.x); v0[2] = v0[2] * bf_lo(g.y) + bf_lo(p.y); v0[3] = v0[3] * bf_hi(g.y) + bf_hi(p.y);
                        v1[0] = v1[0] * bf_lo(g.z) + bf_lo(p.z); v1[1] = v1[1] * bf_hi(g.z) + bf_hi(p.z); v1[2] = v1[2] * bf_lo(g.w) + bf_lo(p.w); v1[3] = v1[3] * bf_hi(g.w) + bf_hi(p.w);
                        u32x4 w; w.x = cvt_pk_bf16(v0[0], v0[1]); w.y = cvt_pk_bf16(v0[2], v0[3]); w.z = cvt_pk_bf16(v1[0], v1[1]); w.w = cvt_pk_bf16(v1[2], v1[3]);
                        st_wt16(rowp + bj * HALF, w);
                    }
                }
            }
            return;
        }
#pragma unroll
        for (int ai = 0; ai < 2; ++ai)
#pragma unroll
            for (int m = 0; m < 4; ++m) {
                const size_t row = (size_t)(row0 + ai * HALF + m * 16);
                bf16_t* rowp = O + row * ldc + col0;
#pragma unroll
                for (int bj = 0; bj < 2; ++bj) {
                    f32x4 v0 = acc[ai][bj][m][0], v1 = acc[ai][bj][m][1];
                    if (mode == 1) {
                        if (m1) {
#pragma unroll
                            for (int i = 0; i < 4; ++i) { v0[i] = fast_sigmoid(v0[i]); v1[i] = fast_sigmoid(v1[i]); }
                        } else { v0 = v0 * sc; v1 = v1 * sc; }
                    } else if (mode == 2) {
#pragma unroll
                        for (int i = 0; i < 4; ++i) { const float a = fmaxf(v0[i], 0.f), b = fmaxf(v1[i], 0.f); v0[i] = a * a; v1[i] = b * b; }
                    } else if (mode >= 3) {
                        const u32x4 g = *(const u32x4*)(Gt + row * ldg + col0 + bj * HALF);
                        v0[0] *= bf_lo(g.x); v0[1] *= bf_hi(g.x); v0[2] *= bf_lo(g.y); v0[3] *= bf_hi(g.y);
                        v1[0] *= bf_lo(g.z); v1[1] *= bf_hi(g.z); v1[2] *= bf_lo(g.w); v1[3] *= bf_hi(g.w);
                        if (mode == 4) {
                            const u32x4 p = *(const u32x4*)(rowp + bj * HALF);
                            v0[0] += bf_lo(p.x); v0[1] += bf_hi(p.x); v0[2] += bf_lo(p.y); v0[3] += bf_hi(p.y);
                            v1[0] += bf_lo(p.z); v1[1] += bf_hi(p.z); v1[2] += bf_lo(p.w); v1[3] += bf_hi(p.w);
                        }
                    }
                    u32x4 w; w.x = cvt_pk_bf16(v0[0], v0[1]); w.y = cvt_pk_bf16(v0[2], v0[3]); w.z = cvt_pk_bf16(v1[0], v1[1]); w.w = cvt_pk_bf16(v1[2], v1[3]);
                    st_wt16(rowp + bj * HALF, w);
                }
            }
    }
};

__device__ __forceinline__ void gemm_phase(LAS unsigned char* lds, const Gemm g, const StaticOrder& S, const Epi& E, const int tid) {
    const int wid = __builtin_amdgcn_readfirstlane(tid >> 6), lane = tid & 63, wr = wid >> 2, wc = wid & 3, fr = lane & 15, fq = lane >> 4;
    const int K = g.K, nt = K / BK, lda = g.lda;
    unsigned voffA[2], voffB[2];
#pragma unroll
    for (int i = 0; i < 2; ++i) { int R, C; stage_rc(tid * 16 + i * 8192, R, C); const int Rb = (R & ~31) + perm32(R & 31);
        voffA[i] = (unsigned)(R * lda + C) * 2u; voffB[i] = (unsigned)(Rb * K + C) * 2u; }
    const size_t kstep = (size_t)(BK * 2);
    const size_t hstepA = (size_t)HALF * lda * 2, hstepB = (size_t)HALF * K * 2;
    const size_t tstepA = 2 * hstepA, tstepB = 2 * hstepB;
    const unsigned ldsw = (unsigned)wid * 1024u;
    const int aoff = lds_byte(wr * 64 + fr, fq * 8), boff = lds_byte(wc * 32 + fr, fq * 8);
#define PG8_SA(b, h) (((b) * 2 + (h)) * HTB)
#define PG8_SB(b, h) ((4 + (b) * 2 + (h)) * HTB)
#define PG8_STAGE(bufoff, gbase, voff) do { _Pragma("unroll") for (int _i = 0; _i < 2; ++_i) \
        __builtin_amdgcn_global_load_lds((const unsigned*)((const char*)(gbase) + (voff)[_i]), (LAS unsigned*)(lds + (bufoff) + ldsw + _i * 8192), 16, 0, 0); } while (0)
#define PG8_LDA(dst, b, h) do { _Pragma("unroll") for (int m = 0; m < 4; ++m) _Pragma("unroll") for (int k = 0; k < 2; ++k) dst[m][k] = *(const LAS bf16x8*)(lds + PG8_SA(b, h) + aoff + m * 2048 + k * 1024); } while (0)
#define PG8_LDB(dst, b, h) do { _Pragma("unroll") for (int n = 0; n < 2; ++n) _Pragma("unroll") for (int k = 0; k < 2; ++k) dst[n][k] = *(const LAS bf16x8*)(lds + PG8_SB(b, h) + boff + n * 2048 + k * 1024); } while (0)
#define PG8_MMA(ai, bj, At, Bt) do { __builtin_amdgcn_s_setprio(1); _Pragma("unroll") for (int m = 0; m < 4; ++m) _Pragma("unroll") for (int n = 0; n < 2; ++n) _Pragma("unroll") for (int k = 0; k < 2; ++k) \
        acc[ai][bj][m][n] = __builtin_amdgcn_mfma_f32_16x16x32_bf16(Bt[n][k], At[m][k], acc[ai][bj][m][n], 0, 0, 0); __builtin_amdgcn_s_setprio(0); } while (0)
#define PG8_WAIT_V(n) asm volatile("s_waitcnt vmcnt(" #n ")" ::: "memory")
#define PG8_WAIT_L(n) asm volatile("s_waitcnt lgkmcnt(" #n ")" ::: "memory")
#define PG8_BAR __builtin_amdgcn_s_barrier()
#define PG8_SCHED __builtin_amdgcn_sched_barrier(0)
    Unit cur, nxt; int ui = 0;
    const bool two = (g.a2 != 0);
    if (!S.next(0, cur)) return;
    f32x4 acc[2][2][4][2];
#pragma unroll
    for (int a = 0; a < 2; ++a)
#pragma unroll
        for (int b = 0; b < 2; ++b)
#pragma unroll
            for (int m = 0; m < 4; ++m)
#pragma unroll
                for (int n = 0; n < 2; ++n) acc[a][b][m][n] = (f32x4){0.f, 0.f, 0.f, 0.f};
    bf16x8 At[4][2], B0[2][2], B1[2][2];
    const char* cA = (const char*)g.A + (size_t)cur.pm * tstepA; const char* cB = (const char*)g.Bt + (size_t)cur.pn * tstepB;
    PG8_STAGE(PG8_SB(0, 0), cB, voffB); PG8_STAGE(PG8_SB(0, 1), cB + hstepB, voffB); PG8_STAGE(PG8_SA(0, 0), cA, voffA); PG8_STAGE(PG8_SA(0, 1), cA + hstepA, voffA);
    if (wr == 1) PG8_BAR;
    PG8_WAIT_V(2); PG8_BAR;
    PG8_STAGE(PG8_SB(1, 0), cB + kstep, voffB); PG8_STAGE(PG8_SA(1, 0), cA + kstep, voffA); PG8_STAGE(PG8_SB(1, 1), cB + hstepB + kstep, voffB);
    PG8_WAIT_V(6); PG8_BAR;
    for (;;) {
        const int nv = ui + 1, npass = two ? (nv & 1) : 0;
        const bool has_next = S.next(two ? (nv >> 1) : nv, nxt);
        const char* nA = has_next ? (const char*)g.A + (size_t)nxt.pm * tstepA + (size_t)npass * g.a2 : cA; const char* nB = has_next ? (const char*)g.Bt + (size_t)nxt.pn * tstepB + (size_t)npass * g.b2 : cB;
        for (int t = 0; t < nt; t += 2) {
            const bool last = (t == nt - 2);
            const char* a1 = cA + (size_t)(t + 1) * kstep;
            const char* a2 = last ? nA : cA + (size_t)(t + 2) * kstep; const char* b2 = last ? nB : cB + (size_t)(t + 2) * kstep;
            const char* a3 = a2 + kstep; const char* b3 = b2 + kstep;
            PG8_LDB(B0, 0, 0); PG8_LDB(B1, 0, 1); PG8_SCHED; PG8_LDA(At, 0, 0); PG8_STAGE(PG8_SA(1, 1), a1 + hstepA, voffA);
            PG8_WAIT_V(8); PG8_WAIT_L(0); PG8_BAR; PG8_MMA(0, 0, At, B0); PG8_MMA(0, 1, At, B1); PG8_BAR; PG8_SCHED;
            PG8_LDA(At, 0, 1); PG8_STAGE(PG8_SB(0, 0), b2, voffB); PG8_STAGE(PG8_SB(0, 1), b2 + hstepB, voffB); PG8_STAGE(PG8_SA(0, 0), a2, voffA);
            PG8_WAIT_V(8); PG8_WAIT_L(0); PG8_BAR; PG8_MMA(1, 0, At, B0); PG8_MMA(1, 1, At, B1); PG8_BAR; PG8_SCHED;
            PG8_LDB(B0, 1, 0); PG8_LDB(B1, 1, 1); PG8_SCHED; PG8_LDA(At, 1, 0); PG8_STAGE(PG8_SA(0, 1), a2 + hstepA, voffA);
            PG8_WAIT_V(8); PG8_WAIT_L(0); PG8_BAR; PG8_MMA(0, 0, At, B0); PG8_MMA(0, 1, At, B1); PG8_BAR; PG8_SCHED;
            PG8_LDA(At, 1, 1); PG8_STAGE(PG8_SB(1, 0), b3, voffB); PG8_STAGE(PG8_SB(1, 1), b3 + hstepB, voffB); PG8_STAGE(PG8_SA(1, 0), a3, voffA);
            PG8_WAIT_V(8); PG8_WAIT_L(0); PG8_BAR; PG8_MMA(1, 0, At, B0); PG8_MMA(1, 1, At, B1); PG8_BAR; PG8_SCHED;
        }
        if (wr == 0) PG8_BAR;
        const bool mid = two && ((ui & 1) == 0);
        if (mid) E.rescale(acc, cur, wr, wc, fr, fq); else E(acc, cur, wr, wc, fr, fq);
        if (!has_next) break;
#pragma unroll
        for (int a = 0; a < 2; ++a)
#pragma unroll
            for (int b = 0; b < 2; ++b)
#pragma unroll
                for (int m = 0; m < 4; ++m)
#pragma unroll
                    for (int n = 0; n < 2; ++n) acc[a][b][m][n] = mid ? acc[a][b][m][n] : (f32x4){0.f, 0.f, 0.f, 0.f};
        cur = nxt; cA = nA; cB = nB; ++ui;
        if (wr == 1) PG8_BAR;
    }
    PG8_WAIT_V(0);
    PG8_BAR;
#undef PG8_SA
#undef PG8_SB
#undef PG8_STAGE
#undef PG8_LDA
#undef PG8_LDB
#undef PG8_MMA
#undef PG8_WAIT_V
#undef PG8_WAIT_L
#undef PG8_BAR
#undef PG8_SCHED
}
}

namespace att {
constexpr int PITCH = INC;
constexpr int LDS_K = 0, LDS_V = 8192, LDS_FLAG = 16384, LDS_OST = 32768;
__device__ __forceinline__ int crow(int r, int hi) { return (r & 3) + 8 * (r >> 2) + 4 * hi; }
#define SBAR() __builtin_amdgcn_sched_barrier(0)
__device__ __forceinline__ void pv(f32x16* o, int vb, bf16x8 pa0, bf16x8 pa1, bf16x8 pa2, bf16x8 pa3) {
#pragma unroll
    for (int d0 = 0; d0 < 2; ++d0) { s16x4 lo[4], hi[4];
#pragma unroll
        for (int ks = 0; ks < 4; ++ks) {
            asm volatile("ds_read_b64_tr_b16 %0,%1 offset:%c2" : "=&v"(lo[ks]) : "v"(vb), "i"(d0 * 4096 + ks * 1024) : "memory");
            asm volatile("ds_read_b64_tr_b16 %0,%1 offset:%c2" : "=&v"(hi[ks]) : "v"(vb), "i"(d0 * 4096 + ks * 1024 + 512) : "memory"); }
        asm volatile("s_waitcnt lgkmcnt(0)" ::: "memory"); SBAR();
#define PK(k) (bf16x8){lo[k][0], lo[k][1], lo[k][2], lo[k][3], hi[k][0], hi[k][1], hi[k][2], hi[k][3]}
        o[d0] = __builtin_amdgcn_mfma_f32_32x32x16_bf16(pa0, PK(0), o[d0], 0, 0, 0);
        o[d0] = __builtin_amdgcn_mfma_f32_32x32x16_bf16(pa1, PK(1), o[d0], 0, 0, 0);
        o[d0] = __builtin_amdgcn_mfma_f32_32x32x16_bf16(pa2, PK(2), o[d0], 0, 0, 0);
        o[d0] = __builtin_amdgcn_mfma_f32_32x32x16_bf16(pa3, PK(3), o[d0], 0, 0, 0);
#undef PK
    }
}
__device__ __forceinline__ float bcast_lo(float v) {
    auto rr = __builtin_amdgcn_permlane32_swap(__builtin_bit_cast(unsigned, v), __builtin_bit_cast(unsigned, v), false, false);
    return __builtin_bit_cast(float, rr[0]);
}
typedef _Float16 half2v __attribute__((ext_vector_type(2)));
template <bool MASK>
__device__ __forceinline__ void score_block(const LAS unsigned char* Kblk  , const int (&koff)[4], const bf16x8 (&qr)[4], const half8 (&tri)[2], int hi, int lim  , float& carry, bf16x8& pa_lo, bf16x8& pa_hi) {
    f32x16 z;
#pragma unroll
    for (int r = 0; r < 16; ++r) z[r] = 0.f;
#pragma unroll
    for (int d0 = 0; d0 < 4; ++d0) {
        const bf16x8 kf = *(const LAS bf16x8*)(Kblk + koff[d0]);
        z = __builtin_amdgcn_mfma_f32_32x32x16_bf16(kf, qr[d0], z, 0, 0, 0);
    }
    const f32x2 cc = (f32x2){carry, carry};
    f32x2 lsc[8]; half2v lh[8]; float nsp0 = 0.f;
#pragma unroll
    for (int p = 0; p < 8; ++p) {
        const f32x2 zp = (f32x2){z[2 * p], z[2 * p + 1]};
        f32x2 e; e.x = __builtin_amdgcn_exp2f(-__builtin_fabsf(zp.x)); e.y = __builtin_amdgcn_exp2f(-__builtin_fabsf(zp.y));
        const f32x2 tt = e + 1.0f;
        f32x2 lg; lg.x = __builtin_amdgcn_logf(tt.x); lg.y = __builtin_amdgcn_logf(tt.y);
        f32x2 mx; mx.x = fmaxf(zp.x, 0.f); mx.y = fmaxf(zp.y, 0.f);
        f32x2 nsp = (-mx) - lg;
        f32x2 ls = zp + nsp;
        if (MASK) {
            const int c0 = ((2 * p) & 3) + 8 * ((2 * p) >> 2);
            const bool v0 = c0 < lim, v1 = (c0 + 1) < lim;
            nsp.x = v0 ? nsp.x : 0.f; nsp.y = v1 ? nsp.y : 0.f;
            ls.x = v0 ? ls.x : -INFINITY; ls.y = v1 ? ls.y : -INFINITY;
        }
        if (p == 0) nsp0 = nsp.x;
        lh[p] = __builtin_convertvector(nsp, half2v);
        lsc[p] = ls + cc;
    }
    half8 lf0, lf1;
#pragma unroll
    for (int p = 0; p < 4; ++p) { lf0[2 * p] = lh[p].x; lf0[2 * p + 1] = lh[p].y; lf1[2 * p] = lh[4 + p].x; lf1[2 * p + 1] = lh[4 + p].y; }
    f32x16 y;
#pragma unroll
    for (int r = 0; r < 16; ++r) y[r] = 0.f;
    y = __builtin_amdgcn_mfma_f32_32x32x16_f16(tri[0], lf0, y, 0, 0, 0);
    y = __builtin_amdgcn_mfma_f32_32x32x16_f16(tri[1], lf1, y, 0, 0, 0);
    unsigned w[8];
#pragma unroll
    for (int p = 0; p < 8; ++p) { const f32x2 ar = lsc[p] + (f32x2){y[2 * p], y[2 * p + 1]}; w[p] = cvt_pk_bf16(__builtin_amdgcn_exp2f(ar.x), __builtin_amdgcn_exp2f(ar.y)); }
    carry = bcast_lo(carry + y[0] + nsp0);
    pa_lo = __builtin_bit_cast(bf16x8, (u32x4){w[0], w[1], w[2], w[3]}); pa_hi = __builtin_bit_cast(bf16x8, (u32x4){w[4], w[5], w[6], w[7]});
}

__device__ __forceinline__ void attn_wave_unit(int b, int h, int qblk, bf16_t* PROJ, LAS unsigned char* wl, const int lane) {
    const int r32 = lane & 31, hi = lane >> 5;
    const long rowbase = (long)b * SEQ; const int qw0 = qblk * 32;
    bf16_t* Qw = PROJ + (rowbase + qw0) * PITCH + 1536 + h * 64;
    const bf16_t* Kh = PROJ + rowbase * PITCH + 2048 + h * 64; const bf16_t* Vh = PROJ + rowbase * PITCH + 2560 + h * 64;
    bf16x8 qr[4];
#pragma unroll
    for (int d0 = 0; d0 < 4; ++d0) qr[d0] = *(const bf16x8*)(Qw + (long)r32 * PITCH + d0 * 16 + hi * 8);
    half8 tri[2];
#pragma unroll
    for (int s = 0; s < 2; ++s)
#pragma unroll
        for (int e = 0; e < 8; ++e) { const int kk = 16 * s + 8 * (e >> 2) + 4 * hi + (e & 3); tri[s][e] = (kk > r32) ? (_Float16)1.0f : (_Float16)0.0f; }
    f32x16 o[2];
#pragma unroll
    for (int r = 0; r < 16; ++r) { o[0][r] = 0.f; o[1][r] = 0.f; }
    float carry = 0.f;
    const int t = qw0 + r32;
    const int skey = lane >> 3, sc8 = lane & 7;
    const bf16_t* kg = Kh + (long)skey * PITCH + sc8 * 8; const bf16_t* vg = Vh + (long)skey * PITCH + sc8 * 8;
    LAS unsigned char* ksl = wl; LAS unsigned char* vsl = wl + 8192;
    int kw[2];
#pragma unroll
    for (int par = 0; par < 2; ++par) kw[par] = skey * 128 + ((sc8 ^ ((4 * par + (skey >> 1)) & 7)) << 4);
    const int vw = (sc8 >> 2) * 4096 + skey * 64 + (sc8 & 3) * 16;
    int koff[4];
#pragma unroll
    for (int d0 = 0; d0 < 4; ++d0) koff[d0] = r32 * 128 + (((2 * d0 + hi) ^ ((r32 >> 1) & 7)) << 4);
    const int vb = (int)(unsigned)(uintptr_t)vsl + ((lane >> 4) & 1) * 32 + (lane & 3) * 8 + (4 * hi + ((lane & 15) >> 2)) * 64;
    int kt = (qw0 + 30) >> 6;
    u32x4 kreg[8], vreg[8];
#pragma unroll
    for (int i = 0; i < 8; ++i) { kreg[i] = *(const u32x4*)(kg + (long)(kt * 64 + 8 * i) * PITCH); vreg[i] = *(const u32x4*)(vg + (long)(kt * 64 + 8 * i) * PITCH); }
    for (;;) {
#pragma unroll
        for (int i = 0; i < 8; ++i) { *(LAS u32x4*)(ksl + i * 1024 + kw[i & 1]) = kreg[i]; *(LAS u32x4*)(vsl + vw + (i >> 1) * 1024 + (i & 1) * 512) = vreg[i]; }
        const int ktn = kt > 0 ? kt - 1 : 0;
#pragma unroll
        for (int i = 0; i < 8; ++i) { kreg[i] = *(const u32x4*)(kg + (long)(ktn * 64 + 8 * i) * PITCH); vreg[i] = *(const u32x4*)(vg + (long)(ktn * 64 + 8 * i) * PITCH); }
        const int kbase = kt * 64;
        const u32x4 zz = (u32x4){0u, 0u, 0u, 0u};
        bf16x8 pa0 = __builtin_bit_cast(bf16x8, zz), pa1 = pa0, pa2 = pa0, pa3 = pa0;
        if (kbase + 32 < qw0 + 31) {
            if (kbase + 63 >= qw0) score_block<true>(ksl + 4096, koff, qr, tri, hi, t - (kbase + 32) - 4 * hi, carry, pa2, pa3);
            else score_block<false>(ksl + 4096, koff, qr, tri, hi, 0, carry, pa2, pa3);
        }
        if (!__all(carry < EXIT_THR)) {
            if (kbase + 31 >= qw0) score_block<true>(ksl, koff, qr, tri, hi, t - kbase - 4 * hi, carry, pa0, pa1);
            else score_block<false>(ksl, koff, qr, tri, hi, 0, carry, pa0, pa1);
        }
        pv(o, vb, pa0, pa1, pa2, pa3);
        if (kt == 0 || __all(carry < EXIT_THR)) break;
        --kt;
    }
    {
        LAS bf16_t* stg = (LAS bf16_t*)wl;
#pragma unroll
        for (int r = 0; r < 16; ++r) { const int orow = crow(r, hi);
#pragma unroll
            for (int d0 = 0; d0 < 2; ++d0) stg[orow * 64 + d0 * 32 + r32] = (bf16_t)(cvt_pk_bf16(o[d0][r], 0.f) & 0xffffu); }
        asm volatile("s_waitcnt lgkmcnt(0)" ::: "memory");
#pragma unroll
        for (int i = 0; i < 4; ++i) { const int row = i * 8 + (lane >> 3), ch = lane & 7; const u32x4 v = *(const LAS u32x4*)(stg + row * 64 + ch * 8); *(u32x4*)(Qw + (long)row * PITCH + ch * 8) = v; }
        asm volatile("s_waitcnt lgkmcnt(0)" ::: "memory");
    }
}
#undef SBAR
}


#define XB_TMO      128
#define XB_XCNT(j)  (256  + 64 * (j))
#define XB_XSUB(j)  (1280 + 64 * (j))
#define XB_XGEN(j)  (2304 + 64 * (j))
#define XB_TOP      3328
#define XB_TOPGEN   3392
#define XCD_BAR_WORDS 3456
#define XB_SPIN_CAP (1u << 22)
__device__ __forceinline__ unsigned xb_ld(unsigned* p)              { return __hip_atomic_load(p, __ATOMIC_RELAXED, __HIP_MEMORY_SCOPE_AGENT); }
__device__ __forceinline__ unsigned xb_add(unsigned* p, unsigned v) { return __hip_atomic_fetch_add(p, v, __ATOMIC_RELAXED, __HIP_MEMORY_SCOPE_AGENT); }
__device__ __forceinline__ unsigned xb_xcc_id() { return (unsigned)__builtin_amdgcn_s_getreg((3 << 11) | 20) & 0xFu; }
#define XB_SPIN(cond, bar) do { unsigned _sp = 0; while (cond) { __builtin_amdgcn_s_sleep(1); \
    if ((++_sp & 255u) == 0u) { if (xb_ld(&(bar)[XB_TMO])) break; if (_sp > XB_SPIN_CAP) { atomicAdd(&(bar)[XB_TMO], 1u); break; } } } } while (0)
struct XcdBarrier { unsigned* bar; unsigned x; volatile LAS unsigned* st; };
__device__ __forceinline__ XcdBarrier xcd_barrier_post(unsigned* bar, volatile LAS unsigned* st, int tid) {
    XcdBarrier b; b.bar = bar; b.x = xb_xcc_id(); b.st = st;
    if (tid == 0) (void)xb_add(&bar[XB_XCNT(b.x)], 1u);
    return b;
}
__device__ __forceinline__ void xcd_barrier_complete(unsigned* bar, unsigned x, unsigned& nloc, unsigned& nx) {
    const unsigned G = gridDim.x * gridDim.y * gridDim.z;
    unsigned sum, cnt, mine, sp = 0u;
    for (;;) {
        sum = 0u; cnt = 0u; mine = 0u;
#pragma unroll
        for (unsigned j = 0; j < 16; ++j) { const unsigned c = xb_ld(&bar[XB_XCNT(j)]); sum += c; cnt += (c > 0u) ? 1u : 0u; mine = (j == x) ? c : mine; }
        if (sum == G) break;
        __builtin_amdgcn_s_sleep(1);
        if ((++sp & 255u) == 0u) { if (xb_ld(&bar[XB_TMO])) break; if (sp > XB_SPIN_CAP) { atomicAdd(&bar[XB_TMO], 1u); break; } }
    }
    nloc = mine > 0u ? mine : 1u; nx = cnt > 0u ? cnt : 1u;
}
__device__ __forceinline__ void xcd_barrier(const XcdBarrier& b, int tid) {
    asm volatile("s_waitcnt vmcnt(0)" ::: "memory");
    __syncthreads();
    if (tid == 0) {
        unsigned* bar = b.bar;
        __builtin_amdgcn_s_waitcnt(0);
        unsigned nloc = b.st[0], nx = b.st[1];
        if (nloc == 0u) { xcd_barrier_complete(bar, b.x, nloc, nx); b.st[0] = nloc; b.st[1] = nx; }
        const unsigned old = xb_add(&bar[XB_XSUB(b.x)], 1u);
        const unsigned gen = old / nloc;
        if (old + 1u == (gen + 1u) * nloc) {
            __builtin_amdgcn_fence(__ATOMIC_RELEASE, "agent");
            asm volatile("s_waitcnt vmcnt(0)" ::: "memory");
            const unsigned og = xb_add(&bar[XB_TOP], 1u);
            const unsigned tg = og / nx;
            if (og + 1u == (tg + 1u) * nx) xb_add(&bar[XB_TOPGEN], 1u);
            else XB_SPIN(xb_ld(&bar[XB_TOPGEN]) == tg, bar);
            __builtin_amdgcn_fence(__ATOMIC_ACQUIRE, "agent");
            xb_add(&bar[XB_XGEN(b.x)], 1u);
            asm volatile("s_waitcnt vmcnt(0)" ::: "memory");
        } else {
            XB_SPIN(xb_ld(&bar[XB_XGEN(b.x)]) == gen, bar);
            __builtin_amdgcn_fence(__ATOMIC_ACQUIRE, "agent");
            asm volatile("s_waitcnt vmcnt(0)" ::: "memory");
        }
    }
    __syncthreads();
}

enum { T_MOD = 0, T_TRANS = 1, T_ROW = 2, T_GEMM = 3, T_ATTN = 4 };
struct PhaseDesc { const void* p[8]; int type, sync, i0, i1, i2, i3, i4, i5; };
constexpr int N_PHASES = 19;
struct Args { PhaseDesc ph[N_PHASES]; unsigned* bar; int ph_lo, ph_hi; int probe_mask, pad; };

__device__ __forceinline__ float wave_sum(float v) {
#pragma unroll
    for (int o = 1; o < 64; o <<= 1) v += __shfl_xor(v, o);
    return v;
}
__device__ __forceinline__ unsigned f2bf(float f) { unsigned u = __builtin_bit_cast(unsigned, f); return (u + 0x7fffu + ((u >> 16) & 1u)) >> 16; }
__device__ __forceinline__ unsigned pk2(float lo, float hi) { return f2bf(lo) | (f2bf(hi) << 16); }

struct TrItem { const float* src; bf16_t* dst; int N, K; };
__device__ __forceinline__ void tr_load(f32x4 (&v)[8], const TrItem& t, int lane) {
#pragma unroll
    for (int i = 0; i < 8; ++i) v[i] = *(const f32x4*)(t.src + (size_t)(8 * i + (lane >> 3)) * t.N + (lane & 7) * 4);
}
__device__ __forceinline__ void tr_store(const f32x4 (&v)[8], const TrItem& t, LAS float* scr, int lane) {
#pragma unroll
    for (int i = 0; i < 8; ++i) { LAS float* p = scr + (8 * i + (lane >> 3)) * 33 + (lane & 7) * 4; p[0] = v[i].x; p[1] = v[i].y; p[2] = v[i].z; p[3] = v[i].w; }
    asm volatile("s_waitcnt lgkmcnt(0)" ::: "memory");
    const int c = lane & 7;
#pragma unroll
    for (int j = 0; j < 4; ++j) { const int n = (lane >> 3) + 8 * j; const LAS float* s = scr + (8 * c) * 33 + n;
        u32x4 o; o.x = cvt_pk_bf16(s[0 * 33], s[1 * 33]); o.y = cvt_pk_bf16(s[2 * 33], s[3 * 33]); o.z = cvt_pk_bf16(s[4 * 33], s[5 * 33]); o.w = cvt_pk_bf16(s[6 * 33], s[7 * 33]);
        *(u32x4*)(t.dst + (size_t)n * t.K + 8 * c) = o; }
    asm volatile("s_waitcnt lgkmcnt(0)" ::: "memory");
}

constexpr int I_IN = (DM / 64) * (INC / 32), I_PC = (CWID / 64) * (DM / 32), I_OUT = (DM / 64) * (DM / 32), I_W1 = (DM / 64) * (FF / 32), I_W2 = (FF / 64) * (DM / 32);
constexpr int I_L = I_IN + 2 * I_PC + I_OUT + I_W1 + I_W2;
__device__ __forceinline__ TrItem tr_decode(const PhaseDesc& d, unsigned char* wbase, int pi, int half) {
    constexpr int P_L = I_L / 2;
    const int l = pi / P_L; int r = pi % P_L; unsigned char* wl = wbase + (size_t)l * WL_SZ;
    const float* W; bf16_t* WT; int N, Kd;
    if (r < I_IN / 2) { W = (const float*)d.p[0] + (size_t)l * DM * INC; N = INC; Kd = DM; WT = (bf16_t*)(wl + WL_IN); }
    else if ((r -= I_IN / 2) < I_PC / 2) { W = (const float*)d.p[1] + (size_t)l * CWID * DM; N = DM; Kd = CWID; WT = (bf16_t*)(wl + WL_PC); }
    else if ((r -= I_PC / 2) < I_PC / 2) { W = (const float*)d.p[2] + (size_t)l * CWID * DM; N = DM; Kd = CWID; WT = (bf16_t*)(wl + WL_PA); }
    else if ((r -= I_PC / 2) < I_OUT / 2) { W = (const float*)d.p[3] + (size_t)l * DM * DM; N = DM; Kd = DM; WT = (bf16_t*)(wl + WL_OUT); }
    else if ((r -= I_OUT / 2) < I_W1 / 2) { W = (const float*)d.p[4] + (size_t)l * DM * FF; N = FF; Kd = DM; WT = (bf16_t*)(wl + WL_W1); }
    else { r -= I_W1 / 2; W = (const float*)d.p[5] + (size_t)l * FF * DM; N = DM; Kd = FF; WT = (bf16_t*)(wl + WL_W2); }
    const int nblk = N / 32, kb = 2 * (r / nblk) + half, nb = r % nblk;
    TrItem t; t.src = W + (size_t)(64 * kb) * N + 32 * nb; t.dst = WT + (size_t)(32 * nb) * Kd + 64 * kb; t.N = N; t.K = Kd; return t;
}

template <bool XBF>
__device__ __forceinline__ void row_phase(int gw, int ngw, int lane, bool has_src, bool has_next, bool xout_bf, const bf16_t* src, const float* xin, float* xout,
                                          const float* g_post, const float* gate  , const float* g_pre, const float* shift, const float* scale, bf16_t* xn) {
    constexpr int XW = XBF ? 2 : 4;
    const int cb = 8 * lane;
    u32x4 xr[2][XW], sr[2][2];
    int m0 = gw, m1 = gw; bool pair = false;
    auto pick = [&](int mA, int& a, int& b, bool& pr) { a = mA; const int mB = mA + ngw; pr = (mB < MT) && ((mB >> 13) == (mA >> 13)); b = pr ? mB : mA; };
    auto load_raw = [&](u32x4 (&X)[2][XW], u32x4 (&S)[2][2], int a, int b) {
#pragma unroll
        for (int r = 0; r < 2; ++r) { const size_t m = (size_t)(r ? b : a);
#pragma unroll
            for (int j = 0; j < 2; ++j) {
                if (XBF) X[r][j] = *(const u32x4*)((const bf16_t*)xin + m * DM + cb + 512 * j);
                else { X[r][2 * j] = *(const u32x4*)(xin + m * DM + cb + 512 * j); X[r][2 * j + 1] = *(const u32x4*)(xin + m * DM + cb + 512 * j + 4); }
                if (has_src) S[r][j] = *(const u32x4*)(src + m * DM + cb + 512 * j); else S[r][j] = (u32x4){0u, 0u, 0u, 0u}; } }
    };
    if (gw >= MT) return;
    pick(gw, m0, m1, pair);
    load_raw(xr, sr, m0, m1);
    for (;;) {
        const int mn = m0 + (pair ? 2 : 1) * ngw; const bool more = mn < MT;
        int n0, n1; bool npair; pick(more ? mn : m0, n0, n1, npair);
        u32x4 xq[2][XW], sq[2][2];
        load_raw(xq, sq, n0, n1);
        const int b = m0 >> 13;
        f32x4 gp[4], gt[4], gq[4], sh[4], sc[4];
#pragma unroll
        for (int jj = 0; jj < 4; ++jj) { const int c = cb + 512 * (jj >> 1) + 4 * (jj & 1);
            gp[jj] = *(const f32x4*)(g_post + c); gt[jj] = *(const f32x4*)(gate + (size_t)b * (NMOD * DM) + c);
            gq[jj] = *(const f32x4*)(g_pre + c); sh[jj] = *(const f32x4*)(shift + (size_t)b * (NMOD * DM) + c); sc[jj] = *(const f32x4*)(scale + (size_t)b * (NMOD * DM) + c); }
        __builtin_amdgcn_sched_barrier(0);
        f32x4 x[2][4];
#pragma unroll
        for (int r = 0; r < 2; ++r)
#pragma unroll
            for (int j = 0; j < 2; ++j) {
                if (XBF) { const u32x4 w = xr[r][j]; x[r][2 * j] = (f32x4){bf_lo(w.x), bf_hi(w.x), bf_lo(w.y), bf_hi(w.y)}; x[r][2 * j + 1] = (f32x4){bf_lo(w.z), bf_hi(w.z), bf_lo(w.w), bf_hi(w.w)}; }
                else { x[r][2 * j] = __builtin_bit_cast(f32x4, xr[r][2 * j]); x[r][2 * j + 1] = __builtin_bit_cast(f32x4, xr[r][2 * j + 1]); } }
        if (has_src) {
            f32x4 s[2][4]; float ss[2];
#pragma unroll
            for (int r = 0; r < 2; ++r) { ss[r] = 0.f;
#pragma unroll
                for (int j = 0; j < 2; ++j) { const u32x4 w = sr[r][j]; s[r][2 * j] = (f32x4){bf_lo(w.x), bf_hi(w.x), bf_lo(w.y), bf_hi(w.y)}; s[r][2 * j + 1] = (f32x4){bf_lo(w.z), bf_hi(w.z), bf_lo(w.w), bf_hi(w.w)}; }
#pragma unroll
                for (int jj = 0; jj < 4; ++jj) ss[r] += (s[r][jj].x * s[r][jj].x + s[r][jj].y * s[r][jj].y) + (s[r][jj].z * s[r][jj].z + s[r][jj].w * s[r][jj].w); }
#pragma unroll
            for (int o = 1; o < 64; o <<= 1) { ss[0] += __shfl_xor(ss[0], o); ss[1] += __shfl_xor(ss[1], o); }
#pragma unroll
            for (int r = 0; r < 2; ++r) { const float rstd = __builtin_amdgcn_rsqf(ss[r] * (1.0f / DM) + EPS); const bool live = (r == 0) || pair; const size_t m = (size_t)(r ? m1 : m0);
#pragma unroll
                for (int jj = 0; jj < 4; ++jj) x[r][jj] = x[r][jj] + gt[jj] * (s[r][jj] * rstd * gp[jj]);
#pragma unroll
                for (int j = 0; j < 2; ++j) {
                    if (xout_bf) { u32x4 w; w.x = cvt_pk_bf16(x[r][2 * j].x, x[r][2 * j].y); w.y = cvt_pk_bf16(x[r][2 * j].z, x[r][2 * j].w); w.z = cvt_pk_bf16(x[r][2 * j + 1].x, x[r][2 * j + 1].y); w.w = cvt_pk_bf16(x[r][2 * j + 1].z, x[r][2 * j + 1].w);
                        if (live) st_wt16((bf16_t*)xout + m * DM + cb + 512 * j, w);
                        x[r][2 * j] = (f32x4){bf_lo(w.x), bf_hi(w.x), bf_lo(w.y), bf_hi(w.y)}; x[r][2 * j + 1] = (f32x4){bf_lo(w.z), bf_hi(w.z), bf_lo(w.w), bf_hi(w.w)}; }
                    else if (live) { st_wt16f(xout + m * DM + cb + 512 * j, x[r][2 * j]); st_wt16f(xout + m * DM + cb + 512 * j + 4, x[r][2 * j + 1]); } } }
        }
        if (has_next) {
            float ss[2];
#pragma unroll
            for (int r = 0; r < 2; ++r) { ss[r] = 0.f;
#pragma unroll
                for (int jj = 0; jj < 4; ++jj) ss[r] += (x[r][jj].x * x[r][jj].x + x[r][jj].y * x[r][jj].y) + (x[r][jj].z * x[r][jj].z + x[r][jj].w * x[r][jj].w); }
#pragma unroll
            for (int o = 1; o < 64; o <<= 1) { ss[0] += __shfl_xor(ss[0], o); ss[1] += __shfl_xor(ss[1], o); }
#pragma unroll
            for (int r = 0; r < 2; ++r) { const float rstd = __builtin_amdgcn_rsqf(ss[r] * (1.0f / DM) + EPS); const bool live = (r == 0) || pair; const size_t m = (size_t)(r ? m1 : m0);
#pragma unroll
                for (int j = 0; j < 2; ++j) { const f32x4 h0 = (x[r][2 * j] * rstd * gq[2 * j]) * (sc[2 * j] + 1.0f) + sh[2 * j], h1 = (x[r][2 * j + 1] * rstd * gq[2 * j + 1]) * (sc[2 * j + 1] + 1.0f) + sh[2 * j + 1];
                    u32x4 w; w.x = cvt_pk_bf16(h0.x, h0.y); w.y = cvt_pk_bf16(h0.z, h0.w); w.z = cvt_pk_bf16(h1.x, h1.y); w.w = cvt_pk_bf16(h1.z, h1.w);
                    if (live) st_wt16(xn + m * DM + cb + 512 * j, w); } }
        }
        if (!more) break;
#pragma unroll
        for (int r = 0; r < 2; ++r) {
#pragma unroll
            for (int j = 0; j < XW; ++j) xr[r][j] = xq[r][j];
            sr[r][0] = sq[r][0]; sr[r][1] = sq[r][1]; }
        m0 = n0; m1 = n1; pair = npair;
    }
}

constexpr int LDS_TOTAL = 131072 + 1024;

__global__ void __launch_bounds__(512, 2) mega_fwd(Args args) {
    __shared__ __attribute__((aligned(16))) unsigned char lds_raw[LDS_TOTAL];
    LAS unsigned char* lds = (LAS unsigned char*)lds_raw;
    volatile LAS unsigned* MISC = (volatile LAS unsigned*)(lds + 131072 + 512);
    if (threadIdx.x < 4) MISC[threadIdx.x] = 0u;
    __syncthreads();
    XcdBarrier xbar = xcd_barrier_post(args.bar, MISC, (int)threadIdx.x);
    unsigned long long probe_acc = 0ull;
    for (int ph = args.ph_lo; ph < args.ph_hi; ++ph) {
        int tid = threadIdx.x; asm volatile("" : "+v"(tid));
        const int lane = tid & 63; const int wave = __builtin_amdgcn_readfirstlane(tid >> 6);
        const int G = gridDim.x, bx = blockIdx.x;
        const int gw = bx * 8 + wave, ngw = G * 8;
        const PhaseDesc& d = args.ph[ph];
        const int type = d.type;
#if PROBE_TIMING
        const unsigned long long t_begin = __builtin_amdgcn_s_memrealtime();
#endif
        if (type == T_GEMM) {
            pg8::Gemm g{(const bf16_t*)d.p[0], (const bf16_t*)d.p[1], MT, d.i0, d.i1, d.i2, (d.i4 == 6) ? 1536 * 2 : 0, (d.i4 == 6) ? (int)(WL_PA - WL_PC) : 0};
            pg8::Epi E{(bf16_t*)d.p[2], d.i3, d.i4, (const bf16_t*)d.p[3], d.i5};
            pg8::StaticOrder S; S.init(MT, g.N, G, bx);
            pg8::gemm_phase(lds, g, S, E, tid);
        } else if (type == T_ATTN) {
            bf16_t* PROJ = (bf16_t*)d.p[0];
            for (int u = gw; u < 16 * 256; u += ngw) { const int bh = u >> 8, qblk = u & 255; att::attn_wave_unit(bh >> 3, bh & 7, qblk, PROJ, lds + wave * 16384, lane); }
            const float* cw = (const float*)d.p[1];
            const int ch = lane * 8;
            float w0[8], w1[8], w2[8];
#pragma unroll
            for (int i = 0; i < 8; ++i) { w0[i] = cw[ch + i]; w1[i] = cw[CWID + ch + i]; w2[i] = cw[2 * CWID + ch + i]; }
            for (int chunk = gw; chunk < MT / 8; chunk += ngw) {
                const int m0 = chunk * 8; const int tpos = m0 & (SEQ - 1);
                const int mlo = (tpos >= 2) ? m0 - 2 : m0;
                u32x4 cc[10], uu[10], bb[8];
#pragma unroll
                for (int i = 0; i < 2; ++i) { cc[i] = *(const u32x4*)(PROJ + (size_t)(mlo + i) * INC + 512 + ch); uu[i] = *(const u32x4*)(PROJ + (size_t)(mlo + i) * INC + 1024 + ch); }
#pragma unroll
                for (int i = 0; i < 8; ++i) { const size_t m = (size_t)(m0 + i); cc[2 + i] = *(const u32x4*)(PROJ + m * INC + 512 + ch); uu[2 + i] = *(const u32x4*)(PROJ + m * INC + 1024 + ch); bb[i] = *(const u32x4*)(PROJ + m * INC + ch); }
                float v2[8], v1[8];
                const float hz = (tpos >= 2) ? 1.f : 0.f;
#pragma unroll
                for (int i = 0; i < 4; ++i) { v2[2 * i] = hz * bf_lo(cc[0][i]) * bf_lo(uu[0][i]); v2[2 * i + 1] = hz * bf_hi(cc[0][i]) * bf_hi(uu[0][i]); v1[2 * i] = hz * bf_lo(cc[1][i]) * bf_lo(uu[1][i]); v1[2 * i + 1] = hz * bf_hi(cc[1][i]) * bf_hi(uu[1][i]); }
#pragma unroll
                for (int i8 = 0; i8 < 8; ++i8) {
                    const size_t m = (size_t)(m0 + i8);
                    float v0[8], y[8];
#pragma unroll
                    for (int i = 0; i < 4; ++i) { v0[2 * i] = bf_lo(cc[2 + i8][i]) * bf_lo(uu[2 + i8][i]); v0[2 * i + 1] = bf_hi(cc[2 + i8][i]) * bf_hi(uu[2 + i8][i]); }
#pragma unroll
                    for (int i = 0; i < 8; ++i) y[i] = w0[i] * v2[i] + w1[i] * v1[i] + w2[i] * v0[i];
                    u32x4 o;
#pragma unroll
                    for (int i = 0; i < 4; ++i) o[i] = cvt_pk_bf16(bf_lo(bb[i8][i]) * y[2 * i], bf_hi(bb[i8][i]) * y[2 * i + 1]);
                    *(u32x4*)(PROJ + m * INC + ch) = o;
#pragma unroll
                    for (int i = 0; i < 8; ++i) { v2[i] = v1[i]; v1[i] = v0[i]; }
                }
            }
        } else if (type == T_ROW) {
            if (d.i4 != 0) row_phase<true>(gw, ngw, lane, d.i0 != 0, d.i1 != 0, d.i5 != 0, (const bf16_t*)d.p[0], (const float*)d.p[1], (float*)d.p[2], (const float*)d.p[3], (const float*)d.p[4],
                      (const float*)d.p[5], (const float*)d.p[6], (const float*)d.p[6] + DM, (bf16_t*)d.p[7]);
            else row_phase<false>(gw, ngw, lane, d.i0 != 0, d.i1 != 0, d.i5 != 0, (const bf16_t*)d.p[0], (const float*)d.p[1], (float*)d.p[2], (const float*)d.p[3], (const float*)d.p[4],
                      (const float*)d.p[5], (const float*)d.p[6], (const float*)d.p[6] + DM, (bf16_t*)d.p[7]);
        } else if (type == T_MOD) {
            const float* w_ada = (const float*)d.p[0]; const float* b_ada = (const float*)d.p[1]; float* MOD = (float*)d.p[2]; const float* cvec = (const float*)d.p[3];
            for (int it = bx; it < 256; it += G) {
                const int l = it >> 7, n0 = (it & 127) * 48, ln = lane < 48 ? lane : 47;
                float a0 = 0.f, a1 = 0.f;
                const float* wp = w_ada + ((size_t)l * DM + wave * 128) * (NMOD * DM) + n0 + ln;
                const float* c0p = cvec + wave * 128; const float* c1p = cvec + DM + wave * 128;
                float cr[2][2];
                cr[0][0] = c0p[lane]; cr[0][1] = c0p[64 + lane]; cr[1][0] = c1p[lane]; cr[1][1] = c1p[64 + lane];
#pragma unroll
                for (int kb = 0; kb < 128; kb += 32) {
                    float wv[32];
#pragma unroll
                    for (int j = 0; j < 32; ++j) wv[j] = wp[(size_t)(kb + j) * (NMOD * DM)];
                    __builtin_amdgcn_sched_barrier(0);
#pragma unroll
                    for (int j = 0; j < 32; ++j) { const int k = kb + j;
                        const float c0 = __builtin_bit_cast(float, __builtin_amdgcn_readlane(__builtin_bit_cast(int, cr[0][k >> 6]), k & 63));
                        const float c1 = __builtin_bit_cast(float, __builtin_amdgcn_readlane(__builtin_bit_cast(int, cr[1][k >> 6]), k & 63));
                        a0 += wv[j] * c0; a1 += wv[j] * c1; }
                }
                LAS float* red = (LAS float*)lds;
                if (lane < 48) { red[(wave * 2 + 0) * 48 + lane] = a0; red[(wave * 2 + 1) * 48 + lane] = a1; }
                __syncthreads();
                if (tid < 96) { const int b = tid / 48, col = tid % 48; float s = b_ada[(size_t)l * (NMOD * DM) + n0 + col];
#pragma unroll
                    for (int w = 0; w < 8; ++w) s += red[(w * 2 + b) * 48 + col];
                    MOD[((size_t)l * 2 + b) * (NMOD * DM) + n0 + col] = s; }
                __syncthreads();
            }
        } else {
            LAS float* scr = (LAS float*)(lds + wave * 16384);
            unsigned char* wbase = (unsigned char*)d.p[6];
            for (int pi = gw; pi < I_L; pi += ngw) {
                f32x4 va[8], vb[8];
                const TrItem ta = tr_decode(d, wbase, pi, 0); tr_load(va, ta, lane);
                const TrItem tb = tr_decode(d, wbase, pi, 1); tr_load(vb, tb, lane);
                tr_store(va, ta, scr, lane);
                tr_store(vb, tb, scr, lane);
            }
        }
#if PROBE_TIMING
        if ((args.probe_mask >> type) & 1) probe_acc += __builtin_amdgcn_s_memrealtime() - t_begin;
        const unsigned long long t_sync = __builtin_amdgcn_s_memrealtime();
#endif
        if (ph + 1 < args.ph_hi) {
            if (d.sync == 2) cg::this_grid().sync();
            else if (d.sync == 1) xcd_barrier(xbar, tid);
        }
#if PROBE_TIMING
        if ((args.probe_mask >> 8) & 1) probe_acc += __builtin_amdgcn_s_memrealtime() - t_sync;
#endif
    }
#if PROBE_TIMING
    { const unsigned long long t0 = __builtin_amdgcn_s_memrealtime(); while (__builtin_amdgcn_s_memrealtime() - t0 < probe_acc) __builtin_amdgcn_s_sleep(8); }
#endif
}

static void build_phases(Args& a, void* const* d_in, void* d_out, void* d_ws) {
    unsigned char* ws = (unsigned char*)d_ws;
    float* MOD = (float*)(ws + WS_MOD); bf16_t* XN = (bf16_t*)(ws + WS_XN); bf16_t* PROJ = (bf16_t*)(ws + WS_PROJ);
    const float* x_in = (const float*)d_in[0];
    const float* g_pre_mix = (const float*)d_in[4]; const float* g_post_mix = (const float*)d_in[5]; const float* g_pre_mlp = (const float*)d_in[6]; const float* g_post_mlp = (const float*)d_in[7];
    float* out = (float*)d_out;
    float* XB0 = (float*)d_out;
    float* XT = (float*)(ws + WS_PROJ + 128 * MiB);
    int n = 0;
    auto add = [&](int type, int sync) -> PhaseDesc& { PhaseDesc& d = a.ph[n++]; d.type = type; d.sync = sync; return d; };
    { PhaseDesc& d = add(T_MOD, 0); d.p[0] = d_in[2]; d.p[1] = d_in[3]; d.p[2] = MOD; d.p[3] = d_in[1]; }
    { PhaseDesc& d = add(T_TRANS, 1); d.p[0] = d_in[8]; d.p[1] = d_in[10]; d.p[2] = d_in[11]; d.p[3] = d_in[12]; d.p[4] = d_in[13]; d.p[5] = d_in[14]; d.p[6] = ws + WS_W; }
    { PhaseDesc& d = add(T_ROW, 1); d.i0 = 0; d.i1 = 1; d.p[0] = XN; d.p[1] = x_in; d.p[2] = out; d.p[3] = g_pre_mix; d.p[4] = MOD; d.p[5] = g_pre_mix; d.p[6] = MOD + 0 * DM; d.p[7] = XN; }
    for (int l = 0; l < 2; ++l) {
        const unsigned char* wl = ws + WS_W + (size_t)l * WL_SZ;
        const float* modl = MOD + (size_t)l * 2 * (NMOD * DM);
        auto gemm = [&](const bf16_t* A, const void* Bt, int N, int K, int lda, bf16_t* O, int ldc, int mode, const bf16_t* Gt, int ldg, int sync) {
            PhaseDesc& d = add(T_GEMM, sync); d.p[0] = A; d.p[1] = Bt; d.p[2] = O; d.p[3] = Gt ? Gt : O; d.i0 = N; d.i1 = K; d.i2 = lda; d.i3 = ldc; d.i4 = mode; d.i5 = ldg; };
        gemm(XN, wl + WL_IN, INC, DM, DM, PROJ, INC, 1, nullptr, 0, 1);
        { PhaseDesc& d = add(T_ATTN, 1); d.p[0] = PROJ; d.p[1] = (const float*)d_in[9] + (size_t)l * 3 * CWID; }
        gemm(PROJ, wl + WL_PC, DM, CWID, INC, XN, DM, 6, PROJ + 4096, INC, 1);
        gemm(XN, wl + WL_OUT, DM, DM, DM, PROJ, DM, 0, nullptr, 0, 1);
        { PhaseDesc& d = add(T_ROW, 1); d.i0 = 1; d.i1 = 1; d.p[0] = PROJ; d.p[1] = (l == 0) ? x_in : XB0; d.p[2] = (l == 0) ? XB0 : XT; d.i4 = (l == 0) ? 0 : 1; d.i5 = 1; d.p[3] = g_post_mix + (size_t)l * DM; d.p[4] = modl + 2 * DM;
          d.p[5] = g_pre_mlp + (size_t)l * DM; d.p[6] = modl + 3 * DM; d.p[7] = XN; }
        gemm(XN, wl + WL_W1, FF, DM, DM, PROJ, FF, 2, nullptr, 0, 1);
        gemm(PROJ, wl + WL_W2, DM, FF, FF, XN, DM, 0, nullptr, 0, 1);
        { const int ln = (l + 1 < 2) ? l + 1 : l; const float* modn = MOD + (size_t)ln * 2 * (NMOD * DM);
          PhaseDesc& d = add(T_ROW, 1); d.i0 = 1; d.i1 = (l == 0) ? 1 : 0; d.p[0] = XN; d.p[1] = (l == 0) ? XB0 : XT; d.p[2] = (l == 0) ? XB0 : out; d.i4 = 1; d.i5 = (l == 0) ? 1 : 0; d.p[3] = g_post_mlp + (size_t)l * DM; d.p[4] = modl + 5 * DM;
          d.p[5] = g_pre_mix + (size_t)ln * DM; d.p[6] = modn + 0 * DM; d.p[7] = XN; }
    }
    if (n != N_PHASES) fprintf(stderr, "phase count mismatch: %d vs %d\n", n, N_PHASES);
}

extern "C" void kernel_launch(void* const* d_in, const int* in_sizes, int n_in, void* d_out, int out_size, void* d_ws, size_t ws_size, hipStream_t stream) {
    static int grid = 0;
    if (grid == 0) {
        int dev = 0, cus = 0, per_cu = 0;
        (void)hipGetDevice(&dev);
        (void)hipDeviceGetAttribute(&cus, hipDeviceAttributeMultiprocessorCount, dev);
        if (hipOccupancyMaxActiveBlocksPerMultiprocessor(&per_cu, (const void*)mega_fwd, 512, 0) != hipSuccess || per_cu < 1) per_cu = 1;
        (void)hipGetLastError();
        if (per_cu > 1) per_cu = 1;
        grid = cus * per_cu;
        if (ws_size < WS_END) fprintf(stderr, "kernel_launch: workspace too small: %zu < %zu\n", ws_size, (size_t)WS_END);
    }
    Args a{};
    build_phases(a, d_in, d_out, d_ws);
    a.bar = (unsigned*)((unsigned char*)d_ws + WS_BAR); a.probe_mask = PROBE_MASK;
    (void)hipMemsetAsync(a.bar, 0, XCD_BAR_WORDS * 4, stream);
#if MULTI_LAUNCH
    for (int ph = 0; ph < N_PHASES;) { int e = ph; while (!a.ph[e].sync) ++e; a.ph_lo = ph; a.ph_hi = e + 1; hipLaunchKernelGGL(mega_fwd, dim3(grid), dim3(512), 0, stream, a); ph = e + 1; }
#else
    a.ph_lo = 0; a.ph_hi = N_PHASES;
    void* kargs[] = {&a};
    hipError_t e = hipLaunchCooperativeKernel((const void*)mega_fwd, dim3(grid), dim3(512), kargs, 0, stream);
    if (e != hipSuccess) fprintf(stderr, "cooperative launch failed: %s (grid %d)\n", hipGetErrorString(e), grid);
#endif
}
```

```cpp
#include <hip/hip_runtime.h>
#include <hip/hip_cooperative_groups.h>
#include <cstdio>
#include <cstdint>
namespace cg = cooperative_groups;

#ifndef MULTI_LAUNCH
#define MULTI_LAUNCH 0
#endif
#ifndef PROBE_TIMING
#define PROBE_TIMING 0
#endif
#ifndef PROBE_MASK
#define PROBE_MASK 0
#endif

#define LAS __attribute__((address_space(3)))
typedef unsigned short bf16_t;
typedef short bf16x8 __attribute__((ext_vector_type(8)));
typedef _Float16 half8 __attribute__((ext_vector_type(8)));
typedef float f32x4 __attribute__((ext_vector_type(4)));
typedef float f32x2 __attribute__((ext_vector_type(2)));
typedef float f32x16 __attribute__((ext_vector_type(16)));
typedef unsigned u32x4 __attribute__((ext_vector_type(4)));
typedef unsigned u32x2 __attribute__((ext_vector_type(2)));
typedef short s16x4 __attribute__((ext_vector_type(4)));

constexpr int DM = 1024, SEQ = 8192, NB = 2, MT = NB * SEQ, INC = 5120, CWID = 512, FF = 4096, NMOD = 6;
constexpr float EPS = 1e-6f;
constexpr float LOG2E = 1.4426950408889634f;
constexpr float QSCALE = 0.125f * LOG2E;
constexpr float EXIT_THR = -150.0f;

constexpr size_t MiB = 1u << 20;
constexpr size_t WS_MOD = 0;
constexpr size_t WS_BAR = 1 * MiB;
constexpr size_t WS_W = 2 * MiB;
constexpr size_t WL_IN = 0, WL_PC = 10 * MiB, WL_PA = 11 * MiB, WL_OUT = 12 * MiB, WL_W1 = 14 * MiB, WL_W2 = 22 * MiB, WL_SZ = 30 * MiB;
constexpr size_t WS_XN = 62 * MiB;
constexpr size_t WS_PROJ = 94 * MiB;
constexpr size_t WS_END = 254 * MiB;

typedef __bf16 bf16x2_t __attribute__((ext_vector_type(2)));
__device__ __forceinline__ unsigned cvt_pk_bf16(float lo, float hi) { f32x2 v = {lo, hi}; bf16x2_t b = __builtin_convertvector(v, bf16x2_t); return __builtin_bit_cast(unsigned, b); }
__device__ __forceinline__ float bf_lo(unsigned w) { return __builtin_bit_cast(float, w << 16); }
__device__ __forceinline__ float bf_hi(unsigned w) { return __builtin_bit_cast(float, w & 0xffff0000u); }
__device__ __forceinline__ float fast_sigmoid(float v) { return __builtin_amdgcn_rcpf(1.0f + __builtin_amdgcn_exp2f(-v * LOG2E)); }

__device__ __forceinline__ void st_wt16(void* p, u32x4 v) { asm volatile("global_store_dwordx4 %0, %1, off sc1\n\ts_nop 1" :: "v"(p), "v"(v) : "memory"); }
__device__ __forceinline__ void st_wt16f(void* p, f32x4 v) { asm volatile("global_store_dwordx4 %0, %1, off sc1\n\ts_nop 1" :: "v"(p), "v"(v) : "memory"); }
__device__ __forceinline__ void st_wt8(void* p, u32x2 v) { asm volatile("global_store_dwordx2 %0, %1, off sc1\n\ts_nop 1" :: "v"(p), "v"(v) : "memory"); }

namespace pg8 {
constexpr int BM = 256, BK = 64, HALF = 128, HTB = HALF * BK * 2, STAGE_BYTES = 8 * HTB, NXCD = 8, WGM = 4;
__host__ __device__ __forceinline__ int lds_byte(int r, int c) { const int st = (r >> 4) * 2 + (c >> 5), rr = r & 15, cc = c & 31, ob = rr * 64 + cc * 2; return st * 1024 + (ob ^ (((ob >> 9) & 1) << 5)); }
__host__ __device__ __forceinline__ void stage_rc(int b, int& R, int& C) { const int st = b / 1024, sb = b % 1024, swz = sb ^ (((sb >> 9) & 1) << 5); R = (st >> 1) * 16 + swz / 64; C = (st & 1) * 32 + (swz % 64) / 2; }
__host__ __device__ __forceinline__ int perm32(int rho) { const int n = rho >> 4, i = rho & 15; return 8 * (i >> 2) + 4 * n + (i & 3); }
struct Unit { int pm, pn; };
struct Gemm { const bf16_t* A; const bf16_t* Bt; int M, N, K, lda; int a2, b2; };
struct StaticOrder {
    int nM, nN, nwg, G, c;
    __device__ void init(int M, int N, int G_, int c_) { nM = M / BM; nN = N / BM; nwg = nM * nN; G = G_; c = c_; }
    __device__ bool next(int i, Unit& u) const {
        const long L = (long)i * G + c; if (L >= nwg) return false;
        int wgid = (int)L; { const int q = nwg / NXCD, r = nwg % NXCD, xcd = wgid % NXCD, off = wgid / NXCD; wgid = (xcd < r ? xcd * (q + 1) : r * (q + 1) + (xcd - r) * q) + off; }
        const int nig = WGM * nN, gid = wgid / nig, fm = gid * WGM, gsz = (nM - fm) < WGM ? (nM - fm) : WGM;
        u.pm = fm + ((wgid % nig) % gsz); u.pn = (wgid % nig) / gsz; return true;
    }
};
constexpr float GB_TINY = 1e-30f;
struct Epi {
    bf16_t* O; int ldc; int mode; const bf16_t* Gt; int ldg;
    __device__ __forceinline__ void rescale(f32x4 (&acc)[2][2][4][2], const Unit& u, int wr, int wc, int fr, int fq) const {
        const int row0 = u.pm * BM + wr * 64 + fr; const int col0 = u.pn * BM + wc * 32 + 8 * fq;
#pragma unroll
        for (int ai = 0; ai < 2; ++ai) {
            u32x4 ga[4][2], gb[4][2];
#pragma unroll
            for (int m = 0; m < 4; ++m)
#pragma unroll
                for (int bj = 0; bj < 2; ++bj) { const bf16_t* gp = Gt + (size_t)(row0 + ai * HALF + m * 16) * ldg + col0 + bj * HALF; gb[m][bj] = *(const u32x4*)gp; ga[m][bj] = *(const u32x4*)(gp - 1024); }
            __builtin_amdgcn_sched_barrier(0);
#pragma unroll
            for (int m = 0; m < 4; ++m)
#pragma unroll
                for (int bj = 0; bj < 2; ++bj) { const u32x4 a = ga[m][bj], b = gb[m][bj];
#define PG8_RATIO(x, y) ((x) * __builtin_amdgcn_rcpf(fmaxf((y), GB_TINY)))
                    acc[ai][bj][m][0][0] *= PG8_RATIO(bf_lo(a.x), bf_lo(b.x)); acc[ai][bj][m][0][1] *= PG8_RATIO(bf_hi(a.x), bf_hi(b.x)); acc[ai][bj][m][0][2] *= PG8_RATIO(bf_lo(a.y), bf_lo(b.y)); acc[ai][bj][m][0][3] *= PG8_RATIO(bf_hi(a.y), bf_hi(b.y));
                    acc[ai][bj][m][1][0] *= PG8_RATIO(bf_lo(a.z), bf_lo(b.z)); acc[ai][bj][m][1][1] *= PG8_RATIO(bf_hi(a.z), bf_hi(b.z)); acc[ai][bj][m][1][2] *= PG8_RATIO(bf_lo(a.w), bf_lo(b.w)); acc[ai][bj][m][1][3] *= PG8_RATIO(bf_hi(a.w), bf_hi(b.w));
#undef PG8_RATIO
                }
        }
    }
    __device__ __forceinline__ void operator()(const f32x4 (&acc)[2][2][4][2], const Unit& u, int wr, int wc, int fr, int fq) const {
        const int row0 = u.pm * BM + wr * 64 + fr; const int col0 = u.pn * BM + wc * 32 + 8 * fq;
        int m1 = 0; float sc = 1.f;
        if (mode == 1) { if (u.pn >= 12) m1 = 1; else if (u.pn == 6 || u.pn == 7) sc = QSCALE; }
        if (mode == 6) {
#pragma unroll
            for (int ai = 0; ai < 2; ++ai) {
                u32x4 gv[4][2];
#pragma unroll
                for (int m = 0; m < 4; ++m)
#pragma unroll
                    for (int bj = 0; bj < 2; ++bj) gv[m][bj] = *(const u32x4*)(Gt + (size_t)(row0 + ai * HALF + m * 16) * ldg + col0 + bj * HALF);
                __builtin_amdgcn_sched_barrier(0);
#pragma unroll
                for (int m = 0; m < 4; ++m) {
                    bf16_t* rowp = O + (size_t)(row0 + ai * HALF + m * 16) * ldc + col0;
#pragma unroll
                    for (int bj = 0; bj < 2; ++bj) {
                        f32x4 v0 = acc[ai][bj][m][0], v1 = acc[ai][bj][m][1]; const u32x4 g = gv[m][bj];
                        v0[0] *= fmaxf(bf_lo(g.x), GB_TINY); v0[1] *= fmaxf(bf_hi(g.x), GB_TINY); v0[2] *= fmaxf(bf_lo(g.y), GB_TINY); v0[3] *= fmaxf(bf_hi(g.y), GB_TINY);
                        v1[0] *= fmaxf(bf_lo(g.z), GB_TINY); v1[1] *= fmaxf(bf_hi(g.z), GB_TINY); v1[2] *= fmaxf(bf_lo(g.w), GB_TINY); v1[3] *= fmaxf(bf_hi(g.w), GB_TINY);
                        u32x4 w; w.x = cvt_pk_bf16(v0[0], v0[1]); w.y = cvt_pk_bf16(v0[2], v0[3]); w.z = cvt_pk_bf16(v1[0], v1[1]); w.w = cvt_pk_bf16(v1[2], v1[3]);
                        st_wt16(rowp + bj * HALF, w);
                    }
                }
            }
            return;
        }
        if (mode >= 3) {
#pragma unroll
            for (int ai = 0; ai < 2; ++ai) {
                u32x4 gv[4][2], pv_[4][2];
#pragma unroll
                for (int m = 0; m < 4; ++m)
#pragma unroll
                    for (int bj = 0; bj < 2; ++bj) {
                        const size_t row = (size_t)(row0 + ai * HALF + m * 16);
                        gv[m][bj] = *(const u32x4*)(Gt + row * ldg + col0 + bj * HALF);
                        pv_[m][bj] = (mode == 4) ? *(const u32x4*)(O + row * ldc + col0 + bj * HALF) : (u32x4){0u, 0u, 0u, 0u};
                    }
                __builtin_amdgcn_sched_barrier(0);
#pragma unroll
                for (int m = 0; m < 4; ++m) {
                    const size_t row = (size_t)(row0 + ai * HALF + m * 16);
                    bf16_t* rowp = O + row * ldc + col0;
#pragma unroll
                    for (int bj = 0; bj < 2; ++bj) {
                        f32x4 v0 = acc[ai][bj][m][0], v1 = acc[ai][bj][m][1];
                        const u32x4 g = gv[m][bj], p = pv_[m][bj];
                        v0[0] = v0[0] * bf_lo(g.x) + bf_lo(p.x); v0[1] = v0[1] * bf_hi(g.x) + bf_hi(p.x); v0[2] = v0[2] * bf_lo(g.y) + bf_lo(p.y); v0[3] = v0[3] * bf_hi(g.y) + bf_hi(p.y);
                        v1[0] = v1[0] * bf_lo(g.z) + bf_lo(p.z); v1[1] = v1[1] * bf_hi(g.z) + bf_hi(p.z); v1[2] = v1[2] * bf_lo(g.w) + bf_lo(p.w); v1[3] = v1[3] * bf_hi(g.w) + bf_hi(p.w);
                        u32x4 w; w.x = cvt_pk_bf16(v0[0], v0[1]); w.y = cvt_pk_bf16(v0[2], v0[3]); w.z = cvt_pk_bf16(v1[0], v1[1]); w.w = cvt_pk_bf16(v1[2], v1[3]);
                        st_wt16(rowp + bj * HALF, w);
                    }
                }
            }
            return;
        }
#pragma unroll
        for (int ai = 0; ai < 2; ++ai)
#pragma unroll
            for (int m = 0; m < 4; ++m) {
                const size_t row = (size_t)(row0 + ai * HALF + m * 16);
                bf16_t* rowp = O + row * ldc + col0;
#pragma unroll
                for (int bj = 0; bj < 2; ++bj) {
                    f32x4 v0 = acc[ai][bj][m][0], v1 = acc[ai][bj][m][1];
                    if (mode == 1) {
                        if (m1) {
#pragma unroll
                            for (int i = 0; i < 4; ++i) { v0[i] = fast_sigmoid(v0[i]); v1[i] = fast_sigmoid(v1[i]); }
                        } else { v0 = v0 * sc; v1 = v1 * sc; }
                    } else if (mode == 2) {
#pragma unroll
                        for (int i = 0; i < 4; ++i) { const float a = fmaxf(v0[i], 0.f), b = fmaxf(v1[i], 0.f); v0[i] = a * a; v1[i] = b * b; }
                    } else if (mode >= 3) {
                        const u32x4 g = *(const u32x4*)(Gt + row * ldg + col0 + bj * HALF);
                        v0[0] *= bf_lo(g.x); v0[1] *= bf_hi(g.x); v0[2] *= bf_lo(g.y); v0[3] *= bf_hi(g.y);
                        v1[0] *= bf_lo(g.z); v1[1] *= bf_hi(g.z); v1[2] *= bf_lo(g.w); v1[3] *= bf_hi(g.w);
                        if (mode == 4) {
                            const u32x4 p = *(const u32x4*)(rowp + bj * HALF);
                            v0[0] += bf_lo(p.x); v0[1] += bf_hi(p.x); v0[2] += bf_lo(p.y); v0[3] += bf_hi(p.y);
                            v1[0] += bf_lo(p.z); v1[1] += bf_hi(p.z); v1[2] += bf_lo(p.w); v1[3] += bf_hi(p.w);
                        }
                    }
                    u32x4 w; w.x = cvt_pk_bf16(v0[0], v0[1]); w.y = cvt_pk_bf16(v0[2], v0[3]); w.z = cvt_pk_bf16(v1[0], v1[1]); w.w = cvt_pk_bf16(v1[2], v1[3]);
                    st_wt16(rowp + bj * HALF, w);
                }
            }
    }
};

__device__ __forceinline__ void gemm_phase(LAS unsigned char* lds, const Gemm g, const StaticOrder& S, const Epi& E, const int tid) {
    const int wid = __builtin_amdgcn_readfirstlane(tid >> 6), lane = tid & 63, wr = wid >> 2, wc = wid & 3, fr = lane & 15, fq = lane >> 4;
    const int K = g.K, nt = K / BK, lda = g.lda;
    unsigned voffA[2], voffB[2];
#pragma unroll
    for (int i = 0; i < 2; ++i) { int R, C; stage_rc(tid * 16 + i * 8192, R, C); const int Rb = (R & ~31) + perm32(R & 31);
        voffA[i] = (unsigned)(R * lda + C) * 2u; voffB[i] = (unsigned)(Rb * K + C) * 2u; }
    const size_t kstep = (size_t)(BK * 2);
    const size_t hstepA = (size_t)HALF * lda * 2, hstepB = (size_t)HALF * K * 2;
    const size_t tstepA = 2 * hstepA, tstepB = 2 * hstepB;
    const unsigned ldsw = (unsigned)wid * 1024u;
    const int aoff = lds_byte(wr * 64 + fr, fq * 8), boff = lds_byte(wc * 32 + fr, fq * 8);
#define PG8_SA(b, h) (((b) * 2 + (h)) * HTB)
#define PG8_SB(b, h) ((4 + (b) * 2 + (h)) * HTB)
#define PG8_STAGE(bufoff, gbase, voff) do { _Pragma("unroll") for (int _i = 0; _i < 2; ++_i) \
        __builtin_amdgcn_global_load_lds((const unsigned*)((const char*)(gbase) + (voff)[_i]), (LAS unsigned*)(lds + (bufoff) + ldsw + _i * 8192), 16, 0, 0); } while (0)
#define PG8_LDA(dst, b, h) do { _Pragma("unroll") for (int m = 0; m < 4; ++m) _Pragma("unroll") for (int k = 0; k < 2; ++k) dst[m][k] = *(const LAS bf16x8*)(lds + PG8_SA(b, h) + aoff + m * 2048 + k * 1024); } while (0)
#define PG8_LDB(dst, b, h) do { _Pragma("unroll") for (int n = 0; n < 2; ++n) _Pragma("unroll") for (int k = 0; k < 2; ++k) dst[n][k] = *(const LAS bf16x8*)(lds + PG8_SB(b, h) + boff + n * 2048 + k * 1024); } while (0)
#define PG8_MMA(ai, bj, At, Bt) do { __builtin_amdgcn_s_setprio(1); _Pragma("unroll") for (int m = 0; m < 4; ++m) _Pragma("unroll") for (int n = 0; n < 2; ++n) _Pragma("unroll") for (int k = 0; k < 2; ++k) \
        acc[ai][bj][m][n] = __builtin_amdgcn_mfma_f32_16x16x32_bf16(Bt[n][k], At[m][k], acc[ai][bj][m][n], 0, 0, 0); __builtin_amdgcn_s_setprio(0); } while (0)
#define PG8_WAIT_V(n) asm volatile("s_waitcnt vmcnt(" #n ")" ::: "memory")
#define PG8_WAIT_L(n) asm volatile("s_waitcnt lgkmcnt(" #n ")" ::: "memory")
#define PG8_BAR __builtin_amdgcn_s_barrier()
#define PG8_SCHED __builtin_amdgcn_sched_barrier(0)
    Unit cur, nxt; int ui = 0;
    const bool two = (g.a2 != 0);
    if (!S.next(0, cur)) return;
    f32x4 acc[2][2][4][2];
#pragma unroll
    for (int a = 0; a < 2; ++a)
#pragma unroll
        for (int b = 0; b < 2; ++b)
#pragma unroll
            for (int m = 0; m < 4; ++m)
#pragma unroll
                for (int n = 0; n < 2; ++n) acc[a][b][m][n] = (f32x4){0.f, 0.f, 0.f, 0.f};
    bf16x8 At[4][2], B0[2][2], B1[2][2];
    const char* cA = (const char*)g.A + (size_t)cur.pm * tstepA; const char* cB = (const char*)g.Bt + (size_t)cur.pn * tstepB;
    PG8_STAGE(PG8_SB(0, 0), cB, voffB); PG8_STAGE(PG8_SB(0, 1), cB + hstepB, voffB); PG8_STAGE(PG8_SA(0, 0), cA, voffA); PG8_STAGE(PG8_SA(0, 1), cA + hstepA, voffA);
    if (wr == 1) PG8_BAR;
    PG8_WAIT_V(2); PG8_BAR;
    PG8_STAGE(PG8_SB(1, 0), cB + kstep, voffB); PG8_STAGE(PG8_SA(1, 0), cA + kstep, voffA); PG8_STAGE(PG8_SB(1, 1), cB + hstepB + kstep, voffB);
    PG8_WAIT_V(6); PG8_BAR;
    for (;;) {
        const int nv = ui + 1, npass = two ? (nv & 1) : 0;
        const bool has_next = S.next(two ? (nv >> 1) : nv, nxt);
        const char* nA = has_next ? (const char*)g.A + (size_t)nxt.pm * tstepA + (size_t)npass * g.a2 : cA; const char* nB = has_next ? (const char*)g.Bt + (size_t)nxt.pn * tstepB + (size_t)npass * g.b2 : cB;
        for (int t = 0; t < nt; t += 2) {
            const bool last = (t == nt - 2);
            const char* a1 = cA + (size_t)(t + 1) * kstep;
            const char* a2 = last ? nA : cA + (size_t)(t + 2) * kstep; const char* b2 = last ? nB : cB + (size_t)(t + 2) * kstep;
            const char* a3 = a2 + kstep; const char* b3 = b2 + kstep;
            PG8_LDB(B0, 0, 0); PG8_LDB(B1, 0, 1); PG8_SCHED; PG8_LDA(At, 0, 0); PG8_STAGE(PG8_SA(1, 1), a1 + hstepA, voffA);
            PG8_WAIT_V(8); PG8_WAIT_L(0); PG8_BAR; PG8_MMA(0, 0, At, B0); PG8_MMA(0, 1, At, B1); PG8_BAR; PG8_SCHED;
            PG8_LDA(At, 0, 1); PG8_STAGE(PG8_SB(0, 0), b2, voffB); PG8_STAGE(PG8_SB(0, 1), b2 + hstepB, voffB); PG8_STAGE(PG8_SA(0, 0), a2, voffA);
            PG8_WAIT_V(8); PG8_WAIT_L(0); PG8_BAR; PG8_MMA(1, 0, At, B0); PG8_MMA(1, 1, At, B1); PG8_BAR; PG8_SCHED;
            PG8_LDB(B0, 1, 0); PG8_LDB(B1, 1, 1); PG8_SCHED; PG8_LDA(At, 1, 0); PG8_STAGE(PG8_SA(0, 1), a2 + hstepA, voffA);
            PG8_WAIT_V(8); PG8_WAIT_L(0); PG8_BAR; PG8_MMA(0, 0, At, B0); PG8_MMA(0, 1, At, B1); PG8_BAR; PG8_SCHED;
            PG8_LDA(At, 1, 1); PG8_STAGE(PG8_SB(1, 0), b3, voffB); PG8_STAGE(PG8_SB(1, 1), b3 + hstepB, voffB); PG8_STAGE(PG8_SA(1, 0), a3, voffA);
            PG8_WAIT_V(8); PG8_WAIT_L(0); PG8_BAR; PG8_MMA(1, 0, At, B0); PG8_MMA(1, 1, At, B1); PG8_BAR; PG8_SCHED;
        }
        if (wr == 0) PG8_BAR;
        const bool mid = two && ((ui & 1) == 0);
        if (mid) E.rescale(acc, cur, wr, wc, fr, fq); else E(acc, cur, wr, wc, fr, fq);
        if (!has_next) break;
#pragma unroll
        for (int a = 0; a < 2; ++a)
#pragma unroll
            for (int b = 0; b < 2; ++b)
#pragma unroll
                for (int m = 0; m < 4; ++m)
#pragma unroll
                    for (int n = 0; n < 2; ++n) acc[a][b][m][n] = mid ? acc[a][b][m][n] : (f32x4){0.f, 0.f, 0.f, 0.f};
        cur = nxt; cA = nA; cB = nB; ++ui;
        if (wr == 1) PG8_BAR;
    }
    PG8_WAIT_V(0);
    PG8_BAR;
#undef PG8_SA
#undef PG8_SB
#undef PG8_STAGE
#undef PG8_LDA
#undef PG8_LDB
#undef PG8_MMA
#undef PG8_WAIT_V
#undef PG8_WAIT_L
#undef PG8_BAR
#undef PG8_SCHED
}
}

namespace att {
constexpr int PITCH = INC;
constexpr int LDS_K = 0, LDS_V = 8192, LDS_FLAG = 16384, LDS_OST = 32768;
__device__ __forceinline__ int crow(int r, int hi) { return (r & 3) + 8 * (r >> 2) + 4 * hi; }
#define SBAR() __builtin_amdgcn_sched_barrier(0)
__device__ __forceinline__ void pv(f32x16* o, int vb, bf16x8 pa0, bf16x8 pa1, bf16x8 pa2, bf16x8 pa3) {
#pragma unroll
    for (int d0 = 0; d0 < 2; ++d0) { s16x4 lo[4], hi[4];
#pragma unroll
        for (int ks = 0; ks < 4; ++ks) {
            asm volatile("ds_read_b64_tr_b16 %0,%1 offset:%c2" : "=&v"(lo[ks]) : "v"(vb), "i"(d0 * 4096 + ks * 1024) : "memory");
            asm volatile("ds_read_b64_tr_b16 %0,%1 offset:%c2" : "=&v"(hi[ks]) : "v"(vb), "i"(d0 * 4096 + ks * 1024 + 512) : "memory"); }
        asm volatile("s_waitcnt lgkmcnt(0)" ::: "memory"); SBAR();
#define PK(k) (bf16x8){lo[k][0], lo[k][1], lo[k][2], lo[k][3], hi[k][0], hi[k][1], hi[k][2], hi[k][3]}
        o[d0] = __builtin_amdgcn_mfma_f32_32x32x16_bf16(pa0, PK(0), o[d0], 0, 0, 0);
        o[d0] = __builtin_amdgcn_mfma_f32_32x32x16_bf16(pa1, PK(1), o[d0], 0, 0, 0);
        o[d0] = __builtin_amdgcn_mfma_f32_32x32x16_bf16(pa2, PK(2), o[d0], 0, 0, 0);
        o[d0] = __builtin_amdgcn_mfma_f32_32x32x16_bf16(pa3, PK(3), o[d0], 0, 0, 0);
#undef PK
    }
}
__device__ __forceinline__ float bcast_lo(float v) {
    auto rr = __builtin_amdgcn_permlane32_swap(__builtin_bit_cast(unsigned, v), __builtin_bit_cast(unsigned, v), false, false);
    return __builtin_bit_cast(float, rr[0]);
}
typedef _Float16 half2v __attribute__((ext_vector_type(2)));
template <bool MASK>
__device__ __forceinline__ void score_block(const LAS unsigned char* Kblk  , const int (&koff)[4], const bf16x8 (&qr)[4], const half8 (&tri)[2], int hi, int lim  , float& carry, bf16x8& pa_lo, bf16x8& pa_hi) {
    f32x16 z;
#pragma unroll
    for (int r = 0; r < 16; ++r) z[r] = 0.f;
#pragma unroll
    for (int d0 = 0; d0 < 4; ++d0) {
        const bf16x8 kf = *(const LAS bf16x8*)(Kblk + koff[d0]);
        z = __builtin_amdgcn_mfma_f32_32x32x16_bf16(kf, qr[d0], z, 0, 0, 0);
    }
    const f32x2 cc = (f32x2){carry, carry};
    f32x2 lsc[8]; half2v lh[8]; float nsp0 = 0.f;
#pragma unroll
    for (int p = 0; p < 8; ++p) {
        const f32x2 zp = (f32x2){z[2 * p], z[2 * p + 1]};
        f32x2 e; e.x = __builtin_amdgcn_exp2f(-__builtin_fabsf(zp.x)); e.y = __builtin_amdgcn_exp2f(-__builtin_fabsf(zp.y));
        const f32x2 tt = e + 1.0f;
        f32x2 lg; lg.x = __builtin_amdgcn_logf(tt.x); lg.y = __builtin_amdgcn_logf(tt.y);
        f32x2 mx; mx.x = fmaxf(zp.x, 0.f); mx.y = fmaxf(zp.y, 0.f);
        f32x2 nsp = (-mx) - lg;
        f32x2 ls = zp + nsp;
        if (MASK) {
            const int c0 = ((2 * p) & 3) + 8 * ((2 * p) >> 2);
            const bool v0 = c0 < lim, v1 = (c0 + 1) < lim;
            nsp.x = v0 ? nsp.x : 0.f; nsp.y = v1 ? nsp.y : 0.f;
            ls.x = v0 ? ls.x : -INFINITY; ls.y = v1 ? ls.y : -INFINITY;
        }
        if (p == 0) nsp0 = nsp.x;
        lh[p] = __builtin_convertvector(nsp, half2v);
        lsc[p] = ls + cc;
    }
    half8 lf0, lf1;
#pragma unroll
    for (int p = 0; p < 4; ++p) { lf0[2 * p] = lh[p].x; lf0[2 * p + 1] = lh[p].y; lf1[2 * p] = lh[4 + p].x; lf1[2 * p + 1] = lh[4 + p].y; }
    f32x16 y;
#pragma unroll
    for (int r = 0; r < 16; ++r) y[r] = 0.f;
    y = __builtin_amdgcn_mfma_f32_32x32x16_f16(tri[0], lf0, y, 0, 0, 0);
    y = __builtin_amdgcn_mfma_f32_32x32x16_f16(tri[1], lf1, y, 0, 0, 0);
    unsigned w[8];
#pragma unroll
    for (int p = 0; p < 8; ++p) { const f32x2 ar = lsc[p] + (f32x2){y[2 * p], y[2 * p + 1]}; w[p] = cvt_pk_bf16(__builtin_amdgcn_exp2f(ar.x), __builtin_amdgcn_exp2f(ar.y)); }
    carry = bcast_lo(carry + y[0] + nsp0);
    pa_lo = __builtin_bit_cast(bf16x8, (u32x4){w[0], w[1], w[2], w[3]}); pa_hi = __builtin_bit_cast(bf16x8, (u32x4){w[4], w[5], w[6], w[7]});
}

__device__ __forceinline__ void attn_wave_unit(int b, int h, int qblk, bf16_t* PROJ, LAS unsigned char* wl, const int lane) {
    const int r32 = lane & 31, hi = lane >> 5;
    const long rowbase = (long)b * SEQ; const int qw0 = qblk * 32;
    bf16_t* Qw = PROJ + (rowbase + qw0) * PITCH + 1536 + h * 64;
    const bf16_t* Kh = PROJ + rowbase * PITCH + 2048 + h * 64; const bf16_t* Vh = PROJ + rowbase * PITCH + 2560 + h * 64;
    bf16x8 qr[4];
#pragma unroll
    for (int d0 = 0; d0 < 4; ++d0) qr[d0] = *(const bf16x8*)(Qw + (long)r32 * PITCH + d0 * 16 + hi * 8);
    half8 tri[2];
#pragma unroll
    for (int s = 0; s < 2; ++s)
#pragma unroll
        for (int e = 0; e < 8; ++e) { const int kk = 16 * s + 8 * (e >> 2) + 4 * hi + (e & 3); tri[s][e] = (kk > r32) ? (_Float16)1.0f : (_Float16)0.0f; }
    f32x16 o[2];
#pragma unroll
    for (int r = 0; r < 16; ++r) { o[0][r] = 0.f; o[1][r] = 0.f; }
    float carry = 0.f;
    const int t = qw0 + r32;
    const int skey = lane >> 3, sc8 = lane & 7;
    const bf16_t* kg = Kh + (long)skey * PITCH + sc8 * 8; const bf16_t* vg = Vh + (long)skey * PITCH + sc8 * 8;
    LAS unsigned char* ksl = wl; LAS unsigned char* vsl = wl + 8192;
    int kw[2];
#pragma unroll
    for (int par = 0; par < 2; ++par) kw[par] = skey * 128 + ((sc8 ^ ((4 * par + (skey >> 1)) & 7)) << 4);
    const int vw = (sc8 >> 2) * 4096 + skey * 64 + (sc8 & 3) * 16;
    int koff[4];
#pragma unroll
    for (int d0 = 0; d0 < 4; ++d0) koff[d0] = r32 * 128 + (((2 * d0 + hi) ^ ((r32 >> 1) & 7)) << 4);
    const int vb = (int)(unsigned)(uintptr_t)vsl + ((lane >> 4) & 1) * 32 + (lane & 3) * 8 + (4 * hi + ((lane & 15) >> 2)) * 64;
    int kt = (qw0 + 30) >> 6;
    u32x4 kreg[8], vreg[8];
#pragma unroll
    for (int i = 0; i < 8; ++i) { kreg[i] = *(const u32x4*)(kg + (long)(kt * 64 + 8 * i) * PITCH); vreg[i] = *(const u32x4*)(vg + (long)(kt * 64 + 8 * i) * PITCH); }
    for (;;) {
#pragma unroll
        for (int i = 0; i < 8; ++i) { *(LAS u32x4*)(ksl + i * 1024 + kw[i & 1]) = kreg[i]; *(LAS u32x4*)(vsl + vw + (i >> 1) * 1024 + (i & 1) * 512) = vreg[i]; }
        const int ktn = kt > 0 ? kt - 1 : 0;
#pragma unroll
        for (int i = 0; i < 8; ++i) { kreg[i] = *(const u32x4*)(kg + (long)(ktn * 64 + 8 * i) * PITCH); vreg[i] = *(const u32x4*)(vg + (long)(ktn * 64 + 8 * i) * PITCH); }
        const int kbase = kt * 64;
        const u32x4 zz = (u32x4){0u, 0u, 0u, 0u};
        bf16x8 pa0 = __builtin_bit_cast(bf16x8, zz), pa1 = pa0, pa2 = pa0, pa3 = pa0;
        if (kbase + 32 < qw0 + 31) {
            if (kbase + 63 >= qw0) score_block<true>(ksl + 4096, koff, qr, tri, hi, t - (kbase + 32) - 4 * hi, carry, pa2, pa3);
            else score_block<false>(ksl + 4096, koff, qr, tri, hi, 0, carry, pa2, pa3);
        }
        if (!__all(carry < EXIT_THR)) {
            if (kbase + 31 >= qw0) score_block<true>(ksl, koff, qr, tri, hi, t - kbase - 4 * hi, carry, pa0, pa1);
            else score_block<false>(ksl, koff, qr, tri, hi, 0, carry, pa0, pa1);
        }
        pv(o, vb, pa0, pa1, pa2, pa3);
        if (kt == 0 || __all(carry < EXIT_THR)) break;
        --kt;
    }
    {
        LAS bf16_t* stg = (LAS bf16_t*)wl;
#pragma unroll
        for (int r = 0; r < 16; ++r) { const int orow = crow(r, hi);
#pragma unroll
            for (int d0 = 0; d0 < 2; ++d0) stg[orow * 64 + d0 * 32 + r32] = (bf16_t)(cvt_pk_bf16(o[d0][r], 0.f) & 0xffffu); }
        asm volatile("s_waitcnt lgkmcnt(0)" ::: "memory");
#pragma unroll
        for (int i = 0; i < 4; ++i) { const int row = i * 8 + (lane >> 3), ch = lane & 7; const u32x4 v = *(const LAS u32x4*)(stg + row * 64 + ch * 8); *(u32x4*)(Qw + (long)row * PITCH + ch * 8) = v; }
        asm volatile("s_waitcnt lgkmcnt(0)" ::: "memory");
    }
}
#undef SBAR
}


#define XB_TMO      128
#define XB_XCNT(j)  (256  + 64 * (j))
#define XB_XSUB(j)  (1280 + 64 * (j))
#define XB_XGEN(j)  (2304 + 64 * (j))
#define XB_TOP      3328
#define XB_TOPGEN   3392
#define XCD_BAR_WORDS 3456
#define XB_SPIN_CAP (1u << 22)
__device__ __forceinline__ unsigned xb_ld(unsigned* p)              { return __hip_atomic_load(p, __ATOMIC_RELAXED, __HIP_MEMORY_SCOPE_AGENT); }
__device__ __forceinline__ unsigned xb_add(unsigned* p, unsigned v) { return __hip_atomic_fetch_add(p, v, __ATOMIC_RELAXED, __HIP_MEMORY_SCOPE_AGENT); }
__device__ __forceinline__ unsigned xb_xcc_id() { return (unsigned)__builtin_amdgcn_s_getreg((3 << 11) | 20) & 0xFu; }
#define XB_SPIN(cond, bar) do { unsigned _sp = 0; while (cond) { __builtin_amdgcn_s_sleep(1); \
    if ((++_sp & 255u) == 0u) { if (xb_ld(&(bar)[XB_TMO])) break; if (_sp > XB_SPIN_CAP) { atomicAdd(&(bar)[XB_TMO], 1u); break; } } } } while (0)
struct XcdBarrier { unsigned* bar; unsigned x; volatile LAS unsigned* st; };
__device__ __forceinline__ XcdBarrier xcd_barrier_post(unsigned* bar, volatile LAS unsigned* st, int tid) {
    XcdBarrier b; b.bar = bar; b.x = xb_xcc_id(); b.st = st;
    if (tid == 0) (void)xb_add(&bar[XB_XCNT(b.x)], 1u);
    return b;
}
__device__ __forceinline__ void xcd_barrier_complete(unsigned* bar, unsigned x, unsigned& nloc, unsigned& nx) {
    const unsigned G = gridDim.x * gridDim.y * gridDim.z;
    unsigned sum, cnt, mine, sp = 0u;
    for (;;) {
        sum = 0u; cnt = 0u; mine = 0u;
#pragma unroll
        for (unsigned j = 0; j < 16; ++j) { const unsigned c = xb_ld(&bar[XB_XCNT(j)]); sum += c; cnt += (c > 0u) ? 1u : 0u; mine = (j == x) ? c : mine; }
        if (sum == G) break;
        __builtin_amdgcn_s_sleep(1);
        if ((++sp & 255u) == 0u) { if (xb_ld(&bar[XB_TMO])) break; if (sp > XB_SPIN_CAP) { atomicAdd(&bar[XB_TMO], 1u); break; } }
    }
    nloc = mine > 0u ? mine : 1u; nx = cnt > 0u ? cnt : 1u;
}
__device__ __forceinline__ void xcd_barrier(const XcdBarrier& b, int tid) {
    asm volatile("s_waitcnt vmcnt(0)" ::: "memory");
    __syncthreads();
    if (tid == 0) {
        unsigned* bar = b.bar;
        __builtin_amdgcn_s_waitcnt(0);
        unsigned nloc = b.st[0], nx = b.st[1];
        if (nloc == 0u) { xcd_barrier_complete(bar, b.x, nloc, nx); b.st[0] = nloc; b.st[1] = nx; }
        const unsigned old = xb_add(&bar[XB_XSUB(b.x)], 1u);
        const unsigned gen = old / nloc;
        if (old + 1u == (gen + 1u) * nloc) {
            __builtin_amdgcn_fence(__ATOMIC_RELEASE, "agent");
            asm volatile("s_waitcnt vmcnt(0)" ::: "memory");
            const unsigned og = xb_add(&bar[XB_TOP], 1u);
            const unsigned tg = og / nx;
            if (og + 1u == (tg + 1u) * nx) xb_add(&bar[XB_TOPGEN], 1u);
            else XB_SPIN(xb_ld(&bar[XB_TOPGEN]) == tg, bar);
            __builtin_amdgcn_fence(__ATOMIC_ACQUIRE, "agent");
            xb_add(&bar[XB_XGEN(b.x)], 1u);
            asm volatile("s_waitcnt vmcnt(0)" ::: "memory");
        } else {
            XB_SPIN(xb_ld(&bar[XB_XGEN(b.x)]) == gen, bar);
            __builtin_amdgcn_fence(__ATOMIC_ACQUIRE, "agent");
            asm volatile("s_waitcnt vmcnt(0)" ::: "memory");
        }
    }
    __syncthreads();
}

enum { T_MOD = 0, T_TRANS = 1, T_ROW = 2, T_GEMM = 3, T_ATTN = 4 };
struct PhaseDesc { const void* p[8]; int type, sync, i0, i1, i2, i3, i4, i5; };
constexpr int N_PHASES = 19;
struct Args { PhaseDesc ph[N_PHASES]; unsigned* bar; int ph_lo, ph_hi; int probe_mask, pad; };

__device__ __forceinline__ float wave_sum(float v) {
#pragma unroll
    for (int o = 1; o < 64; o <<= 1) v += __shfl_xor(v, o);
    return v;
}
__device__ __forceinline__ unsigned f2bf(float f) { unsigned u = __builtin_bit_cast(unsigned, f); return (u + 0x7fffu + ((u >> 16) & 1u)) >> 16; }
__device__ __forceinline__ unsigned pk2(float lo, float hi) { return f2bf(lo) | (f2bf(hi) << 16); }

struct TrItem { const float* src; bf16_t* dst; int N, K; };
__device__ __forceinline__ void tr_load(f32x4 (&v)[8], const TrItem& t, int lane) {
#pragma unroll
    for (int i = 0; i < 8; ++i) v[i] = *(const f32x4*)(t.src + (size_t)(8 * i + (lane >> 3)) * t.N + (lane & 7) * 4);
}
__device__ __forceinline__ void tr_store(const f32x4 (&v)[8], const TrItem& t, LAS float* scr, int lane) {
#pragma unroll
    for (int i = 0; i < 8; ++i) { LAS float* p = scr + (8 * i + (lane >> 3)) * 33 + (lane & 7) * 4; p[0] = v[i].x; p[1] = v[i].y; p[2] = v[i].z; p[3] = v[i].w; }
    asm volatile("s_waitcnt lgkmcnt(0)" ::: "memory");
    const int c = lane & 7;
#pragma unroll
    for (int j = 0; j < 4; ++j) { const int n = (lane >> 3) + 8 * j; const LAS float* s = scr + (8 * c) * 33 + n;
        u32x4 o; o.x = cvt_pk_bf16(s[0 * 33], s[1 * 33]); o.y = cvt_pk_bf16(s[2 * 33], s[3 * 33]); o.z = cvt_pk_bf16(s[4 * 33], s[5 * 33]); o.w = cvt_pk_bf16(s[6 * 33], s[7 * 33]);
        *(u32x4*)(t.dst + (size_t)n * t.K + 8 * c) = o; }
    asm volatile("s_waitcnt lgkmcnt(0)" ::: "memory");
}

constexpr int I_IN = (DM / 64) * (INC / 32), I_PC = (CWID / 64) * (DM / 32), I_OUT = (DM / 64) * (DM / 32), I_W1 = (DM / 64) * (FF / 32), I_W2 = (FF / 64) * (DM / 32);
constexpr int I_L = I_IN + 2 * I_PC + I_OUT + I_W1 + I_W2;
__device__ __forceinline__ TrItem tr_decode(const PhaseDesc& d, unsigned char* wbase, int pi, int half) {
    constexpr int P_L = I_L / 2;
    const int l = pi / P_L; int r = pi % P_L; unsigned char* wl = wbase + (size_t)l * WL_SZ;
    const float* W; bf16_t* WT; int N, Kd;
    if (r < I_IN / 2) { W = (const float*)d.p[0] + (size_t)l * DM * INC; N = INC; Kd = DM; WT = (bf16_t*)(wl + WL_IN); }
    else if ((r -= I_IN / 2) < I_PC / 2) { W = (const float*)d.p[1] + (size_t)l * CWID * DM; N = DM; Kd = CWID; WT = (bf16_t*)(wl + WL_PC); }
    else if ((r -= I_PC / 2) < I_PC / 2) { W = (const float*)d.p[2] + (size_t)l * CWID * DM; N = DM; Kd = CWID; WT = (bf16_t*)(wl + WL_PA); }
    else if ((r -= I_PC / 2) < I_OUT / 2) { W = (const float*)d.p[3] + (size_t)l * DM * DM; N = DM; Kd = DM; WT = (bf16_t*)(wl + WL_OUT); }
    else if ((r -= I_OUT / 2) < I_W1 / 2) { W = (const float*)d.p[4] + (size_t)l * DM * FF; N = FF; Kd = DM; WT = (bf16_t*)(wl + WL_W1); }
    else { r -= I_W1 / 2; W = (const float*)d.p[5] + (size_t)l * FF * DM; N = DM; Kd = FF; WT = (bf16_t*)(wl + WL_W2); }
    const int nblk = N / 32, kb = 2 * (r / nblk) + half, nb = r % nblk;
    TrItem t; t.src = W + (size_t)(64 * kb) * N + 32 * nb; t.dst = WT + (size_t)(32 * nb) * Kd + 64 * kb; t.N = N; t.K = Kd; return t;
}

template <bool XBF>
__device__ __forceinline__ void row_phase(int gw, int ngw, int lane, bool has_src, bool has_next, bool xout_bf, const bf16_t* src, const float* xin, float* xout,
                                          const float* g_post, const float* gate  , const float* g_pre, const float* shift, const float* scale, bf16_t* xn) {
    constexpr int XW = XBF ? 2 : 4;
    const int cb = 8 * lane;
    u32x4 xr[2][XW], sr[2][2];
    int m0 = gw, m1 = gw; bool pair = false;
    auto pick = [&](int mA, int& a, int& b, bool& pr) { a = mA; const int mB = mA + ngw; pr = (mB < MT) && ((mB >> 13) == (mA >> 13)); b = pr ? mB : mA; };
    auto load_raw = [&](u32x4 (&X)[2][XW], u32x4 (&S)[2][2], int a, int b) {
#pragma unroll
        for (int r = 0; r < 2; ++r) { const size_t m = (size_t)(r ? b : a);
#pragma unroll
            for (int j = 0; j < 2; ++j) {
                if (XBF) X[r][j] = *(const u32x4*)((const bf16_t*)xin + m * DM + cb + 512 * j);
                else { X[r][2 * j] = *(const u32x4*)(xin + m * DM + cb + 512 * j); X[r][2 * j + 1] = *(const u32x4*)(xin + m * DM + cb + 512 * j + 4); }
                if (has_src) S[r][j] = *(const u32x4*)(src + m * DM + cb + 512 * j); else S[r][j] = (u32x4){0u, 0u, 0u, 0u}; } }
    };
    if (gw >= MT) return;
    pick(gw, m0, m1, pair);
    load_raw(xr, sr, m0, m1);
    for (;;) {
        const int mn = m0 + (pair ? 2 : 1) * ngw; const bool more = mn < MT;
        int n0, n1; bool npair; pick(more ? mn : m0, n0, n1, npair);
        u32x4 xq[2][XW], sq[2][2];
        load_raw(xq, sq, n0, n1);
        const int b = m0 >> 13;
        f32x4 gp[4], gt[4], gq[4], sh[4], sc[4];
#pragma unroll
        for (int jj = 0; jj < 4; ++jj) { const int c = cb + 512 * (jj >> 1) + 4 * (jj & 1);
            gp[jj] = *(const f32x4*)(g_post + c); gt[jj] = *(const f32x4*)(gate + (size_t)b * (NMOD * DM) + c);
            gq[jj] = *(const f32x4*)(g_pre + c); sh[jj] = *(const f32x4*)(shift + (size_t)b * (NMOD * DM) + c); sc[jj] = *(const f32x4*)(scale + (size_t)b * (NMOD * DM) + c); }
        __builtin_amdgcn_sched_barrier(0);
        f32x4 x[2][4];
#pragma unroll
        for (int r = 0; r < 2; ++r)
#pragma unroll
            for (int j = 0; j < 2; ++j) {
                if (XBF) { const u32x4 w = xr[r][j]; x[r][2 * j] = (f32x4){bf_lo(w.x), bf_hi(w.x), bf_lo(w.y), bf_hi(w.y)}; x[r][2 * j + 1] = (f32x4){bf_lo(w.z), bf_hi(w.z), bf_lo(w.w), bf_hi(w.w)}; }
                else { x[r][2 * j] = __builtin_bit_cast(f32x4, xr[r][2 * j]); x[r][2 * j + 1] = __builtin_bit_cast(f32x4, xr[r][2 * j + 1]); } }
        if (has_src) {
            f32x4 s[2][4]; float ss[2];
#pragma unroll
            for (int r = 0; r < 2; ++r) { ss[r] = 0.f;
#pragma unroll
                for (int j = 0; j < 2; ++j) { const u32x4 w = sr[r][j]; s[r][2 * j] = (f32x4){bf_lo(w.x), bf_hi(w.x), bf_lo(w.y), bf_hi(w.y)}; s[r][2 * j + 1] = (f32x4){bf_lo(w.z), bf_hi(w.z), bf_lo(w.w), bf_hi(w.w)}; }
#pragma unroll
                for (int jj = 0; jj < 4; ++jj) ss[r] += (s[r][jj].x * s[r][jj].x + s[r][jj].y * s[r][jj].y) + (s[r][jj].z * s[r][jj].z + s[r][jj].w * s[r][jj].w); }
#pragma unroll
            for (int o = 1; o < 64; o <<= 1) { ss[0] += __shfl_xor(ss[0], o); ss[1] += __shfl_xor(ss[1], o); }
#pragma unroll
            for (int r = 0; r < 2; ++r) { const float rstd = __builtin_amdgcn_rsqf(ss[r] * (1.0f / DM) + EPS); const bool live = (r == 0) || pair; const size_t m = (size_t)(r ? m1 : m0);
#pragma unroll
                for (int jj = 0; jj < 4; ++jj) x[r][jj] = x[r][jj] + gt[jj] * (s[r][jj] * rstd * gp[jj]);
#pragma unroll
                for (int j = 0; j < 2; ++j) {
                    if (xout_bf) { u32x4 w; w.x = cvt_pk_bf16(x[r][2 * j].x, x[r][2 * j].y); w.y = cvt_pk_bf16(x[r][2 * j].z, x[r][2 * j].w); w.z = cvt_pk_bf16(x[r][2 * j + 1].x, x[r][2 * j + 1].y); w.w = cvt_pk_bf16(x[r][2 * j + 1].z, x[r][2 * j + 1].w);
                        if (live) st_wt16((bf16_t*)xout + m * DM + cb + 512 * j, w);
                        x[r][2 * j] = (f32x4){bf_lo(w.x), bf_hi(w.x), bf_lo(w.y), bf_hi(w.y)}; x[r][2 * j + 1] = (f32x4){bf_lo(w.z), bf_hi(w.z), bf_lo(w.w), bf_hi(w.w)}; }
                    else if (live) { st_wt16f(xout + m * DM + cb + 512 * j, x[r][2 * j]); st_wt16f(xout + m * DM + cb + 512 * j + 4, x[r][2 * j + 1]); } } }
        }
        if (has_next) {
            float ss[2];
#pragma unroll
            for (int r = 0; r < 2; ++r) { ss[r] = 0.f;
#pragma unroll
                for (int jj = 0; jj < 4; ++jj) ss[r] += (x[r][jj].x * x[r][jj].x + x[r][jj].y * x[r][jj].y) + (x[r][jj].z * x[r][jj].z + x[r][jj].w * x[r][jj].w); }
#pragma unroll
            for (int o = 1; o < 64; o <<= 1) { ss[0] += __shfl_xor(ss[0], o); ss[1] += __shfl_xor(ss[1], o); }
#pragma unroll
            for (int r = 0; r < 2; ++r) { const float rstd = __builtin_amdgcn_rsqf(ss[r] * (1.0f / DM) + EPS); const bool live = (r == 0) || pair; const size_t m = (size_t)(r ? m1 : m0);
#pragma unroll
                for (int j = 0; j < 2; ++j) { const f32x4 h0 = (x[r][2 * j] * rstd * gq[2 * j]) * (sc[2 * j] + 1.0f) + sh[2 * j], h1 = (x[r][2 * j + 1] * rstd * gq[2 * j + 1]) * (sc[2 * j + 1] + 1.0f) + sh[2 * j + 1];
                    u32x4 w; w.x = cvt_pk_bf16(h0.x, h0.y); w.y = cvt_pk_bf16(h0.z, h0.w); w.z = cvt_pk_bf16(h1.x, h1.y); w.w = cvt_pk_bf16(h1.z, h1.w);
                    if (live) st_wt16(xn + m * DM + cb + 512 * j, w); } }
        }
        if (!more) break;
#pragma unroll
        for (int r = 0; r < 2; ++r) {
#pragma unroll
            for (int j = 0; j < XW; ++j) xr[r][j] = xq[r][j];
            sr[r][0] = sq[r][0]; sr[r][1] = sq[r][1]; }
        m0 = n0; m1 = n1; pair = npair;
    }
}

constexpr int LDS_TOTAL = 131072 + 1024;

__global__ void __launch_bounds__(512, 2) mega_fwd(Args args) {
    __shared__ __attribute__((aligned(16))) unsigned char lds_raw[LDS_TOTAL];
    LAS unsigned char* lds = (LAS unsigned char*)lds_raw;
    volatile LAS unsigned* MISC = (volatile LAS unsigned*)(lds + 131072 + 512);
    if (threadIdx.x < 4) MISC[threadIdx.x] = 0u;
    __syncthreads();
    XcdBarrier xbar = xcd_barrier_post(args.bar, MISC, (int)threadIdx.x);
    unsigned long long probe_acc = 0ull;
    for (int ph = args.ph_lo; ph < args.ph_hi; ++ph) {
        int tid = threadIdx.x; asm volatile("" : "+v"(tid));
        const int lane = tid & 63; const int wave = __builtin_amdgcn_readfirstlane(tid >> 6);
        const int G = gridDim.x, bx = blockIdx.x;
        const int gw = bx * 8 + wave, ngw = G * 8;
        const PhaseDesc& d = args.ph[ph];
        const int type = d.type;
#if PROBE_TIMING
        const unsigned long long t_begin = __builtin_amdgcn_s_memrealtime();
#endif
        if (type == T_GEMM) {
            pg8::Gemm g{(const bf16_t*)d.p[0], (const bf16_t*)d.p[1], MT, d.i0, d.i1, d.i2, (d.i4 == 6) ? 1536 * 2 : 0, (d.i4 == 6) ? (int)(WL_PA - WL_PC) : 0};
            pg8::Epi E{(bf16_t*)d.p[2], d.i3, d.i4, (const bf16_t*)d.p[3], d.i5};
            pg8::StaticOrder S; S.init(MT, g.N, G, bx);
            pg8::gemm_phase(lds, g, S, E, tid);
        } else if (type == T_ATTN) {
            bf16_t* PROJ = (bf16_t*)d.p[0];
            for (int u = gw; u < 16 * 256; u += ngw) { const int bh = u >> 8, qblk = u & 255; att::attn_wave_unit(bh >> 3, bh & 7, qblk, PROJ, lds + wave * 16384, lane); }
            const float* cw = (const float*)d.p[1];
            const int ch = lane * 8;
            float w0[8], w1[8], w2[8];
#pragma unroll
            for (int i = 0; i < 8; ++i) { w0[i] = cw[ch + i]; w1[i] = cw[CWID + ch + i]; w2[i] = cw[2 * CWID + ch + i]; }
            for (int chunk = gw; chunk < MT / 8; chunk += ngw) {
                const int m0 = chunk * 8; const int tpos = m0 & (SEQ - 1);
                const int mlo = (tpos >= 2) ? m0 - 2 : m0;
                u32x4 cc[10], uu[10], bb[8];
#pragma unroll
                for (int i = 0; i < 2; ++i) { cc[i] = *(const u32x4*)(PROJ + (size_t)(mlo + i) * INC + 512 + ch); uu[i] = *(const u32x4*)(PROJ + (size_t)(mlo + i) * INC + 1024 + ch); }
#pragma unroll
                for (int i = 0; i < 8; ++i) { const size_t m = (size_t)(m0 + i); cc[2 + i] = *(const u32x4*)(PROJ + m * INC + 512 + ch); uu[2 + i] = *(const u32x4*)(PROJ + m * INC + 1024 + ch); bb[i] = *(const u32x4*)(PROJ + m * INC + ch); }
                float v2[8], v1[8];
                const float hz = (tpos >= 2) ? 1.f : 0.f;
#pragma unroll
                for (int i = 0; i < 4; ++i) { v2[2 * i] = hz * bf_lo(cc[0][i]) * bf_lo(uu[0][i]); v2[2 * i + 1] = hz * bf_hi(cc[0][i]) * bf_hi(uu[0][i]); v1[2 * i] = hz * bf_lo(cc[1][i]) * bf_lo(uu[1][i]); v1[2 * i + 1] = hz * bf_hi(cc[1][i]) * bf_hi(uu[1][i]); }
#pragma unroll
                for (int i8 = 0; i8 < 8; ++i8) {
                    const size_t m = (size_t)(m0 + i8);
                    float v0[8], y[8];
#pragma unroll
                    for (int i = 0; i < 4; ++i) { v0[2 * i] = bf_lo(cc[2 + i8][i]) * bf_lo(uu[2 + i8][i]); v0[2 * i + 1] = bf_hi(cc[2 + i8][i]) * bf_hi(uu[2 + i8][i]); }
#pragma unroll
                    for (int i = 0; i < 8; ++i) y[i] = w0[i] * v2[i] + w1[i] * v1[i] + w2[i] * v0[i];
                    u32x4 o;
#pragma unroll
                    for (int i = 0; i < 4; ++i) o[i] = cvt_pk_bf16(bf_lo(bb[i8][i]) * y[2 * i], bf_hi(bb[i8][i]) * y[2 * i + 1]);
                    *(u32x4*)(PROJ + m * INC + ch) = o;
#pragma unroll
                    for (int i = 0; i < 8; ++i) { v2[i] = v1[i]; v1[i] = v0[i]; }
                }
            }
        } else if (type == T_ROW) {
            if (d.i4 != 0) row_phase<true>(gw, ngw, lane, d.i0 != 0, d.i1 != 0, d.i5 != 0, (const bf16_t*)d.p[0], (const float*)d.p[1], (float*)d.p[2], (const float*)d.p[3], (const float*)d.p[4],
                      (const float*)d.p[5], (const float*)d.p[6], (const float*)d.p[6] + DM, (bf16_t*)d.p[7]);
            else row_phase<false>(gw, ngw, lane, d.i0 != 0, d.i1 != 0, d.i5 != 0, (const bf16_t*)d.p[0], (const float*)d.p[1], (float*)d.p[2], (const float*)d.p[3], (const float*)d.p[4],
                      (const float*)d.p[5], (const float*)d.p[6], (const float*)d.p[6] + DM, (bf16_t*)d.p[7]);
        } else if (type == T_MOD) {
            const float* w_ada = (const float*)d.p[0]; const float* b_ada = (const float*)d.p[1]; float* MOD = (float*)d.p[2]; const float* cvec = (const float*)d.p[3];
            LAS float* cl = (LAS float*)(lds + 65536);
            LAS float* part = (LAS float*)lds;
            for (int i = tid; i < 2 * DM; i += 512) cl[i] = cvec[i];
            __syncthreads();
            for (int it = bx; it < 256; it += G) {
                const int l = it >> 7, n0 = (it & 127) * 48;
                const int lc = lane < 60 ? lane : 59, rg = lc / 12, ch = lc - 12 * rg;
                const float* wp = w_ada + ((size_t)l * DM + wave * 128) * (NMOD * DM) + n0 + 4 * ch;
                f32x4 wv[26];
                const float* pr = wp + (size_t)rg * (NMOD * DM);
#pragma unroll
                for (int i = 0; i < 25; ++i) { wv[i] = *(const f32x4*)pr; pr += (size_t)5 * (NMOD * DM); }
                wv[25] = *(const f32x4*)(wp + (size_t)(rg < 3 ? 125 + rg : 127) * (NMOD * DM));
                __builtin_amdgcn_sched_barrier(0);
                f32x4 a0 = (f32x4){0.f, 0.f, 0.f, 0.f}, a1 = a0;
#pragma unroll
                for (int i = 0; i < 26; ++i) { const int kr = 5 * i + rg; const bool ok = (kr < 128) && (lane < 60); const int kk = wave * 128 + (kr < 128 ? kr : 127);
                    const float c0 = ok ? cl[kk] : 0.f, c1 = ok ? cl[DM + kk] : 0.f; a0 += wv[i] * c0; a1 += wv[i] * c1; }
                LAS float* pp = part + (wave * 64 + lane) * 8;
                pp[0] = a0.x; pp[1] = a0.y; pp[2] = a0.z; pp[3] = a0.w; pp[4] = a1.x; pp[5] = a1.y; pp[6] = a1.z; pp[7] = a1.w;
                __syncthreads();
                if (tid < 96) { const int b = tid / 48, col = tid % 48, c4 = col >> 2, e = col & 3; float s = b_ada[(size_t)l * (NMOD * DM) + n0 + col];
#pragma unroll
                    for (int w = 0; w < 8; ++w)
#pragma unroll
                        for (int r = 0; r < 5; ++r) s += part[(w * 64 + 12 * r + c4) * 8 + b * 4 + e];
                    MOD[((size_t)l * 2 + b) * (NMOD * DM) + n0 + col] = s; }
                __syncthreads();
            }
        } else {
            LAS float* scr = (LAS float*)(lds + wave * 16384);
            unsigned char* wbase = (unsigned char*)d.p[6];
            for (int pi = gw; pi < I_L; pi += ngw) {
                f32x4 va[8], vb[8];
                const TrItem ta = tr_decode(d, wbase, pi, 0); tr_load(va, ta, lane);
                const TrItem tb = tr_decode(d, wbase, pi, 1); tr_load(vb, tb, lane);
                tr_store(va, ta, scr, lane);
                tr_store(vb, tb, scr, lane);
            }
        }
#if PROBE_TIMING
        if ((args.probe_mask >> type) & 1) probe_acc += __builtin_amdgcn_s_memrealtime() - t_begin;
        const unsigned long long t_sync = __builtin_amdgcn_s_memrealtime();
#endif
        if (ph + 1 < args.ph_hi) {
            if (d.sync == 2) cg::this_grid().sync();
            else if (d.sync == 1) xcd_barrier(xbar, tid);
        }
#if PROBE_TIMING
        if ((args.probe_mask >> 8) & 1) probe_acc += __builtin_amdgcn_s_memrealtime() - t_sync;
#endif
    }
#if PROBE_TIMING
    { const unsigned long long t0 = __builtin_amdgcn_s_memrealtime(); while (__builtin_amdgcn_s_memrealtime() - t0 < probe_acc) __builtin_amdgcn_s_sleep(8); }
#endif
}

static void build_phases(Args& a, void* const* d_in, void* d_out, void* d_ws) {
    unsigned char* ws = (unsigned char*)d_ws;
    float* MOD = (float*)(ws + WS_MOD); bf16_t* XN = (bf16_t*)(ws + WS_XN); bf16_t* PROJ = (bf16_t*)(ws + WS_PROJ);
    const float* x_in = (const float*)d_in[0];
    const float* g_pre_mix = (const float*)d_in[4]; const float* g_post_mix = (const float*)d_in[5]; const float* g_pre_mlp = (const float*)d_in[6]; const float* g_post_mlp = (const float*)d_in[7];
    float* out = (float*)d_out;
    float* XB0 = (float*)d_out;
    float* XT = (float*)(ws + WS_PROJ + 128 * MiB);
    int n = 0;
    auto add = [&](int type, int sync) -> PhaseDesc& { PhaseDesc& d = a.ph[n++]; d.type = type; d.sync = sync; return d; };
    { PhaseDesc& d = add(T_MOD, 0); d.p[0] = d_in[2]; d.p[1] = d_in[3]; d.p[2] = MOD; d.p[3] = d_in[1]; }
    { PhaseDesc& d = add(T_TRANS, 1); d.p[0] = d_in[8]; d.p[1] = d_in[10]; d.p[2] = d_in[11]; d.p[3] = d_in[12]; d.p[4] = d_in[13]; d.p[5] = d_in[14]; d.p[6] = ws + WS_W; }
    { PhaseDesc& d = add(T_ROW, 1); d.i0 = 0; d.i1 = 1; d.p[0] = XN; d.p[1] = x_in; d.p[2] = out; d.p[3] = g_pre_mix; d.p[4] = MOD; d.p[5] = g_pre_mix; d.p[6] = MOD + 0 * DM; d.p[7] = XN; }
    for (int l = 0; l < 2; ++l) {
        const unsigned char* wl = ws + WS_W + (size_t)l * WL_SZ;
        const float* modl = MOD + (size_t)l * 2 * (NMOD * DM);
        auto gemm = [&](const bf16_t* A, const void* Bt, int N, int K, int lda, bf16_t* O, int ldc, int mode, const bf16_t* Gt, int ldg, int sync) {
            PhaseDesc& d = add(T_GEMM, sync); d.p[0] = A; d.p[1] = Bt; d.p[2] = O; d.p[3] = Gt ? Gt : O; d.i0 = N; d.i1 = K; d.i2 = lda; d.i3 = ldc; d.i4 = mode; d.i5 = ldg; };
        gemm(XN, wl + WL_IN, INC, DM, DM, PROJ, INC, 1, nullptr, 0, 1);
        { PhaseDesc& d = add(T_ATTN, 1); d.p[0] = PROJ; d.p[1] = (const float*)d_in[9] + (size_t)l * 3 * CWID; }
        gemm(PROJ, wl + WL_PC, DM, CWID, INC, XN, DM, 6, PROJ + 4096, INC, 1);
        gemm(XN, wl + WL_OUT, DM, DM, DM, PROJ, DM, 0, nullptr, 0, 1);
        { PhaseDesc& d = add(T_ROW, 1); d.i0 = 1; d.i1 = 1; d.p[0] = PROJ; d.p[1] = (l == 0) ? x_in : XB0; d.p[2] = (l == 0) ? XB0 : XT; d.i4 = (l == 0) ? 0 : 1; d.i5 = 1; d.p[3] = g_post_mix + (size_t)l * DM; d.p[4] = modl + 2 * DM;
          d.p[5] = g_pre_mlp + (size_t)l * DM; d.p[6] = modl + 3 * DM; d.p[7] = XN; }
        gemm(XN, wl + WL_W1, FF, DM, DM, PROJ, FF, 2, nullptr, 0, 1);
        gemm(PROJ, wl + WL_W2, DM, FF, FF, XN, DM, 0, nullptr, 0, 1);
        { const int ln = (l + 1 < 2) ? l + 1 : l; const float* modn = MOD + (size_t)ln * 2 * (NMOD * DM);
          PhaseDesc& d = add(T_ROW, 1); d.i0 = 1; d.i1 = (l == 0) ? 1 : 0; d.p[0] = XN; d.p[1] = (l == 0) ? XB0 : XT; d.p[2] = (l == 0) ? XB0 : out; d.i4 = 1; d.i5 = (l == 0) ? 1 : 0; d.p[3] = g_post_mlp + (size_t)l * DM; d.p[4] = modl + 5 * DM;
          d.p[5] = g_pre_mix + (size_t)ln * DM; d.p[6] = modn + 0 * DM; d.p[7] = XN; }
    }
    if (n != N_PHASES) fprintf(stderr, "phase count mismatch: %d vs %d\n", n, N_PHASES);
}

extern "C" void kernel_launch(void* const* d_in, const int* in_sizes, int n_in, void* d_out, int out_size, void* d_ws, size_t ws_size, hipStream_t stream) {
    static int grid = 0;
    if (grid == 0) {
        int dev = 0, cus = 0, per_cu = 0;
        (void)hipGetDevice(&dev);
        (void)hipDeviceGetAttribute(&cus, hipDeviceAttributeMultiprocessorCount, dev);
        if (hipOccupancyMaxActiveBlocksPerMultiprocessor(&per_cu, (const void*)mega_fwd, 512, 0) != hipSuccess || per_cu < 1) per_cu = 1;
        (void)hipGetLastError();
        if (per_cu > 1) per_cu = 1;
        grid = cus * per_cu;
        if (ws_size < WS_END) fprintf(stderr, "kernel_launch: workspace too small: %zu < %zu\n", ws_size, (size_t)WS_END);
    }
    Args a{};
    build_phases(a, d_in, d_out, d_ws);
    a.bar = (unsigned*)((unsigned char*)d_ws + WS_BAR); a.probe_mask = PROBE_MASK;
    (void)hipMemsetAsync(a.bar, 0, XCD_BAR_WORDS * 4, stream);
#if MULTI_LAUNCH
    for (int ph = 0; ph < N_PHASES;) { int e = ph; while (!a.ph[e].sync) ++e; a.ph_lo = ph; a.ph_hi = e + 1; hipLaunchKernelGGL(mega_fwd, dim3(grid), dim3(512), 0, stream, a); ph = e + 1; }
#else
    a.ph_lo = 0; a.ph_hi = N_PHASES;
    void* kargs[] = {&a};
    hipError_t e = hipLaunchCooperativeKernel((const void*)mega_fwd, dim3(grid), dim3(512), kargs, 0, stream);
    if (e != hipSuccess) fprintf(stderr, "cooperative launch failed: %s (grid %d)\n", hipGetErrorString(e), grid);
#endif
}
```

```cpp
#include <hip/hip_runtime.h>
#include <hip/hip_cooperative_groups.h>
#include <cstdio>
#include <cstdint>
namespace cg = cooperative_groups;

#ifndef MULTI_LAUNCH
#define MULTI_LAUNCH 0
#endif
#ifndef PROBE_TIMING
#define PROBE_TIMING 0
#endif
#ifndef PROBE_MASK
#define PROBE_MASK 0
#endif

#define LAS __attribute__((address_space(3)))
typedef unsigned short bf16_t;
typedef short bf16x8 __attribute__((ext_vector_type(8)));
typedef _Float16 half8 __attribute__((ext_vector_type(8)));
typedef float f32x4 __attribute__((ext_vector_type(4)));
typedef float f32x2 __attribute__((ext_vector_type(2)));
typedef float f32x16 __attribute__((ext_vector_type(16)));
typedef unsigned u32x4 __attribute__((ext_vector_type(4)));
typedef unsigned u32x2 __attribute__((ext_vector_type(2)));
typedef short s16x4 __attribute__((ext_vector_type(4)));

constexpr int DM = 1024, SEQ = 8192, NB = 2, MT = NB * SEQ, INC = 5120, CWID = 512, FF = 4096, NMOD = 6;
constexpr float EPS = 1e-6f;
constexpr float LOG2E = 1.4426950408889634f;
constexpr float QSCALE = 0.125f * LOG2E;
constexpr float EXIT_THR = -150.0f;

constexpr size_t MiB = 1u << 20;
constexpr size_t WS_MOD = 0;
constexpr size_t WS_BAR = 1 * MiB;
constexpr size_t WS_W = 2 * MiB;
constexpr size_t WL_IN = 0, WL_PC = 10 * MiB, WL_PA = 11 * MiB, WL_OUT = 12 * MiB, WL_W1 = 14 * MiB, WL_W2 = 22 * MiB, WL_SZ = 30 * MiB;
constexpr size_t WS_XN = 62 * MiB;
constexpr size_t WS_PROJ = 94 * MiB;
constexpr size_t WS_END = 254 * MiB;

typedef __bf16 bf16x2_t __attribute__((ext_vector_type(2)));
__device__ __forceinline__ unsigned cvt_pk_bf16(float lo, float hi) { f32x2 v = {lo, hi}; bf16x2_t b = __builtin_convertvector(v, bf16x2_t); return __builtin_bit_cast(unsigned, b); }
__device__ __forceinline__ float bf_lo(unsigned w) { return __builtin_bit_cast(float, w << 16); }
__device__ __forceinline__ float bf_hi(unsigned w) { return __builtin_bit_cast(float, w & 0xffff0000u); }
__device__ __forceinline__ float fast_sigmoid(float v) { return __builtin_amdgcn_rcpf(1.0f + __builtin_amdgcn_exp2f(-v * LOG2E)); }

__device__ __forceinline__ void st_wt16(void* p, u32x4 v) { asm volatile("global_store_dwordx4 %0, %1, off sc1\n\ts_nop 1" :: "v"(p), "v"(v) : "memory"); }
__device__ __forceinline__ void st_wt16f(void* p, f32x4 v) { asm volatile("global_store_dwordx4 %0, %1, off sc1\n\ts_nop 1" :: "v"(p), "v"(v) : "memory"); }
__device__ __forceinline__ void st_wt8(void* p, u32x2 v) { asm volatile("global_store_dwordx2 %0, %1, off sc1\n\ts_nop 1" :: "v"(p), "v"(v) : "memory"); }

namespace pg8 {
constexpr int BM = 256, BK = 64, HALF = 128, HTB = HALF * BK * 2, STAGE_BYTES = 8 * HTB, NXCD = 8, WGM = 4;
__host__ __device__ __forceinline__ int lds_byte(int r, int c) { const int st = (r >> 4) * 2 + (c >> 5), rr = r & 15, cc = c & 31, ob = rr * 64 + cc * 2; return st * 1024 + (ob ^ (((ob >> 9) & 1) << 5)); }
__host__ __device__ __forceinline__ void stage_rc(int b, int& R, int& C) { const int st = b / 1024, sb = b % 1024, swz = sb ^ (((sb >> 9) & 1) << 5); R = (st >> 1) * 16 + swz / 64; C = (st & 1) * 32 + (swz % 64) / 2; }
__host__ __device__ __forceinline__ int perm32(int rho) { const int n = rho >> 4, i = rho & 15; return 8 * (i >> 2) + 4 * n + (i & 3); }
struct Unit { int pm, pn; };
struct Gemm { const bf16_t* A; const bf16_t* Bt; int M, N, K, lda; int a2, b2; };
struct StaticOrder {
    int nM, nN, nwg, G, c;
    __device__ void init(int M, int N, int G_, int c_) { nM = M / BM; nN = N / BM; nwg = nM * nN; G = G_; c = c_; }
    __device__ bool next(int i, Unit& u) const {
        const long L = (long)i * G + c; if (L >= nwg) return false;
        int wgid = (int)L; { const int q = nwg / NXCD, r = nwg % NXCD, xcd = wgid % NXCD, off = wgid / NXCD; wgid = (xcd < r ? xcd * (q + 1) : r * (q + 1) + (xcd - r) * q) + off; }
        const int nig = WGM * nN, gid = wgid / nig, fm = gid * WGM, gsz = (nM - fm) < WGM ? (nM - fm) : WGM;
        u.pm = fm + ((wgid % nig) % gsz); u.pn = (wgid % nig) / gsz; return true;
    }
};
constexpr float GB_TINY = 1e-30f;
struct Epi {
    bf16_t* O; int ldc; int mode; const bf16_t* Gt; int ldg;
    __device__ __forceinline__ void rescale(f32x4 (&acc)[2][2][4][2], const Unit& u, int wr, int wc, int fr, int fq) const {
        const int row0 = u.pm * BM + wr * 64 + fr; const int col0 = u.pn * BM + wc * 32 + 8 * fq;
#pragma unroll
        for (int ai = 0; ai < 2; ++ai) {
            u32x4 ga[4][2], gb[4][2];
#pragma unroll
            for (int m = 0; m < 4; ++m)
#pragma unroll
                for (int bj = 0; bj < 2; ++bj) { const bf16_t* gp = Gt + (size_t)(row0 + ai * HALF + m * 16) * ldg + col0 + bj * HALF; gb[m][bj] = *(const u32x4*)gp; ga[m][bj] = *(const u32x4*)(gp - 1024); }
            __builtin_amdgcn_sched_barrier(0);
#pragma unroll
            for (int m = 0; m < 4; ++m)
#pragma unroll
                for (int bj = 0; bj < 2; ++bj) { const u32x4 a = ga[m][bj], b = gb[m][bj];
#define PG8_RATIO(x, y) ((x) * __builtin_amdgcn_rcpf(fmaxf((y), GB_TINY)))
                    acc[ai][bj][m][0][0] *= PG8_RATIO(bf_lo(a.x), bf_lo(b.x)); acc[ai][bj][m][0][1] *= PG8_RATIO(bf_hi(a.x), bf_hi(b.x)); acc[ai][bj][m][0][2] *= PG8_RATIO(bf_lo(a.y), bf_lo(b.y)); acc[ai][bj][m][0][3] *= PG8_RATIO(bf_hi(a.y), bf_hi(b.y));
                    acc[ai][bj][m][1][0] *= PG8_RATIO(bf_lo(a.z), bf_lo(b.z)); acc[ai][bj][m][1][1] *= PG8_RATIO(bf_hi(a.z), bf_hi(b.z)); acc[ai][bj][m][1][2] *= PG8_RATIO(bf_lo(a.w), bf_lo(b.w)); acc[ai][bj][m][1][3] *= PG8_RATIO(bf_hi(a.w), bf_hi(b.w));
#undef PG8_RATIO
                }
        }
    }
    __device__ __forceinline__ void operator()(const f32x4 (&acc)[2][2][4][2], const Unit& u, int wr, int wc, int fr, int fq) const {
        const int row0 = u.pm * BM + wr * 64 + fr; const int col0 = u.pn * BM + wc * 32 + 8 * fq;
        int m1 = 0; float sc = 1.f;
        if (mode == 1) { if (u.pn >= 12) m1 = 1; else if (u.pn == 6 || u.pn == 7) sc = QSCALE; }
        if (mode == 6) {
#pragma unroll
            for (int ai = 0; ai < 2; ++ai) {
                u32x4 gv[4][2];
#pragma unroll
                for (int m = 0; m < 4; ++m)
#pragma unroll
                    for (int bj = 0; bj < 2; ++bj) gv[m][bj] = *(const u32x4*)(Gt + (size_t)(row0 + ai * HALF + m * 16) * ldg + col0 + bj * HALF);
                __builtin_amdgcn_sched_barrier(0);
#pragma unroll
                for (int m = 0; m < 4; ++m) {
                    bf16_t* rowp = O + (size_t)(row0 + ai * HALF + m * 16) * ldc + col0;
#pragma unroll
                    for (int bj = 0; bj < 2; ++bj) {
                        f32x4 v0 = acc[ai][bj][m][0], v1 = acc[ai][bj][m][1]; const u32x4 g = gv[m][bj];
                        v0[0] *= fmaxf(bf_lo(g.x), GB_TINY); v0[1] *= fmaxf(bf_hi(g.x), GB_TINY); v0[2] *= fmaxf(bf_lo(g.y), GB_TINY); v0[3] *= fmaxf(bf_hi(g.y), GB_TINY);
                        v1[0] *= fmaxf(bf_lo(g.z), GB_TINY); v1[1] *= fmaxf(bf_hi(g.z), GB_TINY); v1[2] *= fmaxf(bf_lo(g.w), GB_TINY); v1[3] *= fmaxf(bf_hi(g.w), GB_TINY);
                        u32x4 w; w.x = cvt_pk_bf16(v0[0], v0[1]); w.y = cvt_pk_bf16(v0[2], v0[3]); w.z = cvt_pk_bf16(v1[0], v1[1]); w.w = cvt_pk_bf16(v1[2], v1[3]);
                        st_wt16(rowp + bj * HALF, w);
                    }
                }
            }
            return;
        }
        if (mode >= 3) {
#pragma unroll
            for (int ai = 0; ai < 2; ++ai) {
                u32x4 gv[4][2], pv_[4][2];
#pragma unroll
                for (int m = 0; m < 4; ++m)
#pragma unroll
                    for (int bj = 0; bj < 2; ++bj) {
                        const size_t row = (size_t)(row0 + ai * HALF + m * 16);
                        gv[m][bj] = *(const u32x4*)(Gt + row * ldg + col0 + bj * HALF);
                        pv_[m][bj] = (mode == 4) ? *(const u32x4*)(O + row * ldc + col0 + bj * HALF) : (u32x4){0u, 0u, 0u, 0u};
                    }
                __builtin_amdgcn_sched_barrier(0);
#pragma unroll
                for (int m = 0; m < 4; ++m) {
                    const size_t row = (size_t)(row0 + ai * HALF + m * 16);
                    bf16_t* rowp = O + row * ldc + col0;
#pragma unroll
                    for (int bj = 0; bj < 2; ++bj) {
                        f32x4 v0 = acc[ai][bj][m][0], v1 = acc[ai][bj][m][1];
                        const u32x4 g = gv[m][bj], p = pv_[m][bj];
                        v0[0] = v0[0] * bf_lo(g.x) + bf_lo(p.x); v0[1] = v0[1] * bf_hi(g.x) + bf_hi(p.x); v0[2] = v0[2] * bf_lo(g.y) + bf_lo(p.y); v0[3] = v0[3] * bf_hi(g.y) + bf_hi(p.y);
                        v1[0] = v1[0] * bf_lo(g.z) + bf_lo(p.z); v1[1] = v1[1] * bf_hi(g.z) + bf_hi(p.z); v1[2] = v1[2] * bf_lo(g.w) + bf_lo(p.w); v1[3] = v1[3] * bf_hi(g.w) + bf_hi(p.w);
                        u32x4 w; w.x = cvt_pk_bf16(v0[0], v0[1]); w.y = cvt_pk_bf16(v0[2], v0[3]); w.z = cvt_pk_bf16(v1[0], v1[1]); w.w = cvt_pk_bf16(v1[2], v1[3]);
                        st_wt16(rowp + bj * HALF, w);
                    }
                }
            }
            return;
        }
#pragma unroll
        for (int ai = 0; ai < 2; ++ai)
#pragma unroll
            for (int m = 0; m < 4; ++m) {
                const size_t row = (size_t)(row0 + ai * HALF + m * 16);
                bf16_t* rowp = O + row * ldc + col0;
#pragma unroll
                for (int bj = 0; bj < 2; ++bj) {
                    f32x4 v0 = acc[ai][bj][m][0], v1 = acc[ai][bj][m][1];
                    if (mode == 1) {
                        if (m1) {
#pragma unroll
                            for (int i = 0; i < 4; ++i) { v0[i] = fast_sigmoid(v0[i]); v1[i] = fast_sigmoid(v1[i]); }
                        } else { v0 = v0 * sc; v1 = v1 * sc; }
                    } else if (mode == 2) {
#pragma unroll
                        for (int i = 0; i < 4; ++i) { const float a = fmaxf(v0[i], 0.f), b = fmaxf(v1[i], 0.f); v0[i] = a * a; v1[i] = b * b; }
                    } else if (mode >= 3) {
                        const u32x4 g = *(const u32x4*)(Gt + row * ldg + col0 + bj * HALF);
                        v0[0] *= bf_lo(g.x); v0[1] *= bf_hi(g.x); v0[2] *= bf_lo(g.y); v0[3] *= bf_hi(g.y);
                        v1[0] *= bf_lo(g.z); v1[1] *= bf_hi(g.z); v1[2] *= bf_lo(g.w); v1[3] *= bf_hi(g.w);
                        if (mode == 4) {
                            const u32x4 p = *(const u32x4*)(rowp + bj * HALF);
                            v0[0] += bf_lo(p.x); v0[1] += bf_hi(p.x); v0[2] += bf_lo(p.y); v0[3] += bf_hi(p.y);
                            v1[0] += bf_lo(p.z); v1[1] += bf_hi(p.z); v1[2] += bf_lo(p.w); v1[3] += bf_hi(p.w);
                        }
                    }
                    u32x4 w; w.x = cvt_pk_bf16(v0[0], v0[1]); w.y = cvt_pk_bf16(v0[2], v0[3]); w.z = cvt_pk_bf16(v1[0], v1[1]); w.w = cvt_pk_bf16(v1[2], v1[3]);
                    st_wt16(rowp + bj * HALF, w);
                }
            }
    }
};

__device__ __forceinline__ void gemm_phase(LAS unsigned char* lds, const Gemm g, const StaticOrder& S, const Epi& E, const int tid) {
    const int wid = __builtin_amdgcn_readfirstlane(tid >> 6), lane = tid & 63, wr = wid >> 2, wc = wid & 3, fr = lane & 15, fq = lane >> 4;
    const int K = g.K, nt = K / BK, lda = g.lda;
    unsigned voffA[2], voffB[2];
#pragma unroll
    for (int i = 0; i < 2; ++i) { int R, C; stage_rc(tid * 16 + i * 8192, R, C); const int Rb = (R & ~31) + perm32(R & 31);
        voffA[i] = (unsigned)(R * lda + C) * 2u; voffB[i] = (unsigned)(Rb * K + C) * 2u; }
    const size_t kstep = (size_t)(BK * 2);
    const size_t hstepA = (size_t)HALF * lda * 2, hstepB = (size_t)HALF * K * 2;
    const size_t tstepA = 2 * hstepA, tstepB = 2 * hstepB;
    const unsigned ldsw = (unsigned)wid * 1024u;
    const int aoff = lds_byte(wr * 64 + fr, fq * 8), boff = lds_byte(wc * 32 + fr, fq * 8);
#define PG8_SA(b, h) (((b) * 2 + (h)) * HTB)
#define PG8_SB(b, h) ((4 + (b) * 2 + (h)) * HTB)
#define PG8_STAGE(bufoff, gbase, voff) do { _Pragma("unroll") for (int _i = 0; _i < 2; ++_i) \
        __builtin_amdgcn_global_load_lds((const unsigned*)((const char*)(gbase) + (voff)[_i]), (LAS unsigned*)(lds + (bufoff) + ldsw + _i * 8192), 16, 0, 0); } while (0)
#define PG8_LDA(dst, b, h) do { _Pragma("unroll") for (int m = 0; m < 4; ++m) _Pragma("unroll") for (int k = 0; k < 2; ++k) dst[m][k] = *(const LAS bf16x8*)(lds + PG8_SA(b, h) + aoff + m * 2048 + k * 1024); } while (0)
#define PG8_LDB(dst, b, h) do { _Pragma("unroll") for (int n = 0; n < 2; ++n) _Pragma("unroll") for (int k = 0; k < 2; ++k) dst[n][k] = *(const LAS bf16x8*)(lds + PG8_SB(b, h) + boff + n * 2048 + k * 1024); } while (0)
#define PG8_MMA(ai, bj, At, Bt) do { __builtin_amdgcn_s_setprio(1); _Pragma("unroll") for (int m = 0; m < 4; ++m) _Pragma("unroll") for (int n = 0; n < 2; ++n) _Pragma("unroll") for (int k = 0; k < 2; ++k) \
        acc[ai][bj][m][n] = __builtin_amdgcn_mfma_f32_16x16x32_bf16(Bt[n][k], At[m][k], acc[ai][bj][m][n], 0, 0, 0); __builtin_amdgcn_s_setprio(0); } while (0)
#define PG8_WAIT_V(n) asm volatile("s_waitcnt vmcnt(" #n ")" ::: "memory")
#define PG8_WAIT_L(n) asm volatile("s_waitcnt lgkmcnt(" #n ")" ::: "memory")
#define PG8_BAR __builtin_amdgcn_s_barrier()
#define PG8_SCHED __builtin_amdgcn_sched_barrier(0)
    Unit cur, nxt; int ui = 0;
    const bool two = (g.a2 != 0);
    if (!S.next(0, cur)) return;
    f32x4 acc[2][2][4][2];
#pragma unroll
    for (int a = 0; a < 2; ++a)
#pragma unroll
        for (int b = 0; b < 2; ++b)
#pragma unroll
            for (int m = 0; m < 4; ++m)
#pragma unroll
                for (int n = 0; n < 2; ++n) acc[a][b][m][n] = (f32x4){0.f, 0.f, 0.f, 0.f};
    bf16x8 At[4][2], B0[2][2], B1[2][2];
    const char* cA = (const char*)g.A + (size_t)cur.pm * tstepA; const char* cB = (const char*)g.Bt + (size_t)cur.pn * tstepB;
    PG8_STAGE(PG8_SB(0, 0), cB, voffB); PG8_STAGE(PG8_SB(0, 1), cB + hstepB, voffB); PG8_STAGE(PG8_SA(0, 0), cA, voffA); PG8_STAGE(PG8_SA(0, 1), cA + hstepA, voffA);
    if (wr == 1) PG8_BAR;
    PG8_WAIT_V(2); PG8_BAR;
    PG8_STAGE(PG8_SB(1, 0), cB + kstep, voffB); PG8_STAGE(PG8_SA(1, 0), cA + kstep, voffA); PG8_STAGE(PG8_SB(1, 1), cB + hstepB + kstep, voffB);
    PG8_WAIT_V(6); PG8_BAR;
    for (;;) {
        const int nv = ui + 1, npass = two ? (nv & 1) : 0;
        const bool has_next = S.next(two ? (nv >> 1) : nv, nxt);
        const char* nA = has_next ? (const char*)g.A + (size_t)nxt.pm * tstepA + (size_t)npass * g.a2 : cA; const char* nB = has_next ? (const char*)g.Bt + (size_t)nxt.pn * tstepB + (size_t)npass * g.b2 : cB;
        for (int t = 0; t < nt; t += 2) {
            const bool last = (t == nt - 2);
            const char* a1 = cA + (size_t)(t + 1) * kstep;
            const char* a2 = last ? nA : cA + (size_t)(t + 2) * kstep; const char* b2 = last ? nB : cB + (size_t)(t + 2) * kstep;
            const char* a3 = a2 + kstep; const char* b3 = b2 + kstep;
            PG8_LDB(B0, 0, 0); PG8_LDB(B1, 0, 1); PG8_SCHED; PG8_LDA(At, 0, 0); PG8_STAGE(PG8_SA(1, 1), a1 + hstepA, voffA);
            PG8_WAIT_V(8); PG8_WAIT_L(0); PG8_BAR; PG8_MMA(0, 0, At, B0); PG8_MMA(0, 1, At, B1); PG8_BAR; PG8_SCHED;
            PG8_LDA(At, 0, 1); PG8_STAGE(PG8_SB(0, 0), b2, voffB); PG8_STAGE(PG8_SB(0, 1), b2 + hstepB, voffB); PG8_STAGE(PG8_SA(0, 0), a2, voffA);
            PG8_WAIT_V(8); PG8_WAIT_L(0); PG8_BAR; PG8_MMA(1, 0, At, B0); PG8_MMA(1, 1, At, B1); PG8_BAR; PG8_SCHED;
            PG8_LDB(B0, 1, 0); PG8_LDB(B1, 1, 1); PG8_SCHED; PG8_LDA(At, 1, 0); PG8_STAGE(PG8_SA(0, 1), a2 + hstepA, voffA);
            PG8_WAIT_V(8); PG8_WAIT_L(0); PG8_BAR; PG8_MMA(0, 0, At, B0); PG8_MMA(0, 1, At, B1); PG8_BAR; PG8_SCHED;
            PG8_LDA(At, 1, 1); PG8_STAGE(PG8_SB(1, 0), b3, voffB); PG8_STAGE(PG8_SB(1, 1), b3 + hstepB, voffB); PG8_STAGE(PG8_SA(1, 0), a3, voffA);
            PG8_WAIT_V(8); PG8_WAIT_L(0); PG8_BAR; PG8_MMA(1, 0, At, B0); PG8_MMA(1, 1, At, B1); PG8_BAR; PG8_SCHED;
        }
        if (wr == 0) PG8_BAR;
        const bool mid = two && ((ui & 1) == 0);
        if (mid) E.rescale(acc, cur, wr, wc, fr, fq); else E(acc, cur, wr, wc, fr, fq);
        if (!has_next) break;
#pragma unroll
        for (int a = 0; a < 2; ++a)
#pragma unroll
            for (int b = 0; b < 2; ++b)
#pragma unroll
                for (int m = 0; m < 4; ++m)
#pragma unroll
                    for (int n = 0; n < 2; ++n) acc[a][b][m][n] = mid ? acc[a][b][m][n] : (f32x4){0.f, 0.f, 0.f, 0.f};
        cur = nxt; cA = nA; cB = nB; ++ui;
        if (wr == 1) PG8_BAR;
    }
    PG8_WAIT_V(0);
    PG8_BAR;
#undef PG8_SA
#undef PG8_SB
#undef PG8_STAGE
#undef PG8_LDA
#undef PG8_LDB
#undef PG8_MMA
#undef PG8_WAIT_V
#undef PG8_WAIT_L
#undef PG8_BAR
#undef PG8_SCHED
}
}

namespace att {
constexpr int PITCH = INC;
constexpr int LDS_K = 0, LDS_V = 8192, LDS_FLAG = 16384, LDS_OST = 32768;
__device__ __forceinline__ int crow(int r, int hi) { return (r & 3) + 8 * (r >> 2) + 4 * hi; }
#define SBAR() __builtin_amdgcn_sched_barrier(0)
__device__ __forceinline__ void pv(f32x16* o, int vb, bf16x8 pa0, bf16x8 pa1, bf16x8 pa2, bf16x8 pa3) {
#pragma unroll
    for (int d0 = 0; d0 < 2; ++d0) { s16x4 lo[4], hi[4];
#pragma unroll
        for (int ks = 0; ks < 4; ++ks) {
            asm volatile("ds_read_b64_tr_b16 %0,%1 offset:%c2" : "=&v"(lo[ks]) : "v"(vb), "i"(d0 * 4096 + ks * 1024) : "memory");
            asm volatile("ds_read_b64_tr_b16 %0,%1 offset:%c2" : "=&v"(hi[ks]) : "v"(vb), "i"(d0 * 4096 + ks * 1024 + 512) : "memory"); }
        asm volatile("s_waitcnt lgkmcnt(0)" ::: "memory"); SBAR();
#define PK(k) (bf16x8){lo[k][0], lo[k][1], lo[k][2], lo[k][3], hi[k][0], hi[k][1], hi[k][2], hi[k][3]}
        o[d0] = __builtin_amdgcn_mfma_f32_32x32x16_bf16(pa0, PK(0), o[d0], 0, 0, 0);
        o[d0] = __builtin_amdgcn_mfma_f32_32x32x16_bf16(pa1, PK(1), o[d0], 0, 0, 0);
        o[d0] = __builtin_amdgcn_mfma_f32_32x32x16_bf16(pa2, PK(2), o[d0], 0, 0, 0);
        o[d0] = __builtin_amdgcn_mfma_f32_32x32x16_bf16(pa3, PK(3), o[d0], 0, 0, 0);
#undef PK
    }
}
__device__ __forceinline__ float bcast_lo(float v) {
    auto rr = __builtin_amdgcn_permlane32_swap(__builtin_bit_cast(unsigned, v), __builtin_bit_cast(unsigned, v), false, false);
    return __builtin_bit_cast(float, rr[0]);
}
typedef _Float16 half2v __attribute__((ext_vector_type(2)));
template <bool MASK>
__device__ __forceinline__ void score_block(const LAS unsigned char* Kblk  , const int (&koff)[4], const bf16x8 (&qr)[4], const half8 (&tri)[2], int hi, int lim  , float& carry, bf16x8& pa_lo, bf16x8& pa_hi) {
    f32x16 z;
#pragma unroll
    for (int r = 0; r < 16; ++r) z[r] = 0.f;
#pragma unroll
    for (int d0 = 0; d0 < 4; ++d0) {
        const bf16x8 kf = *(const LAS bf16x8*)(Kblk + koff[d0]);
        z = __builtin_amdgcn_mfma_f32_32x32x16_bf16(kf, qr[d0], z, 0, 0, 0);
    }
    const f32x2 cc = (f32x2){carry, carry};
    f32x2 lsc[8]; half2v lh[8]; float nsp0 = 0.f;
#pragma unroll
    for (int p = 0; p < 8; ++p) {
        const f32x2 zp = (f32x2){z[2 * p], z[2 * p + 1]};
        f32x2 e; e.x = __builtin_amdgcn_exp2f(-__builtin_fabsf(zp.x)); e.y = __builtin_amdgcn_exp2f(-__builtin_fabsf(zp.y));
        const f32x2 tt = e + 1.0f;
        f32x2 lg; lg.x = __builtin_amdgcn_logf(tt.x); lg.y = __builtin_amdgcn_logf(tt.y);
        f32x2 mx; mx.x = fmaxf(zp.x, 0.f); mx.y = fmaxf(zp.y, 0.f);
        f32x2 nsp = (-mx) - lg;
        f32x2 ls = zp + nsp;
        if (MASK) {
            const int c0 = ((2 * p) & 3) + 8 * ((2 * p) >> 2);
            const bool v0 = c0 < lim, v1 = (c0 + 1) < lim;
            nsp.x = v0 ? nsp.x : 0.f; nsp.y = v1 ? nsp.y : 0.f;
            ls.x = v0 ? ls.x : -INFINITY; ls.y = v1 ? ls.y : -INFINITY;
        }
        if (p == 0) nsp0 = nsp.x;
        lh[p] = __builtin_convertvector(nsp, half2v);
        lsc[p] = ls + cc;
    }
    half8 lf0, lf1;
#pragma unroll
    for (int p = 0; p < 4; ++p) { lf0[2 * p] = lh[p].x; lf0[2 * p + 1] = lh[p].y; lf1[2 * p] = lh[4 + p].x; lf1[2 * p + 1] = lh[4 + p].y; }
    f32x16 y;
#pragma unroll
    for (int r = 0; r < 16; ++r) y[r] = 0.f;
    y = __builtin_amdgcn_mfma_f32_32x32x16_f16(tri[0], lf0, y, 0, 0, 0);
    y = __builtin_amdgcn_mfma_f32_32x32x16_f16(tri[1], lf1, y, 0, 0, 0);
    unsigned w[8];
#pragma unroll
    for (int p = 0; p < 8; ++p) { const f32x2 ar = lsc[p] + (f32x2){y[2 * p], y[2 * p + 1]}; w[p] = cvt_pk_bf16(__builtin_amdgcn_exp2f(ar.x), __builtin_amdgcn_exp2f(ar.y)); }
    carry = bcast_lo(carry + y[0] + nsp0);
    pa_lo = __builtin_bit_cast(bf16x8, (u32x4){w[0], w[1], w[2], w[3]}); pa_hi = __builtin_bit_cast(bf16x8, (u32x4){w[4], w[5], w[6], w[7]});
}

__device__ __forceinline__ void attn_wave_unit(int b, int h, int qblk, bf16_t* PROJ, LAS unsigned char* wl, const int lane) {
    const int r32 = lane & 31, hi = lane >> 5;
    const long rowbase = (long)b * SEQ; const int qw0 = qblk * 32;
    bf16_t* Qw = PROJ + (rowbase + qw0) * PITCH + 1536 + h * 64;
    const bf16_t* Kh = PROJ + rowbase * PITCH + 2048 + h * 64; const bf16_t* Vh = PROJ + rowbase * PITCH + 2560 + h * 64;
    bf16x8 qr[4];
#pragma unroll
    for (int d0 = 0; d0 < 4; ++d0) qr[d0] = *(const bf16x8*)(Qw + (long)r32 * PITCH + d0 * 16 + hi * 8);
    half8 tri[2];
#pragma unroll
    for (int s = 0; s < 2; ++s)
#pragma unroll
        for (int e = 0; e < 8; ++e) { const int kk = 16 * s + 8 * (e >> 2) + 4 * hi + (e & 3); tri[s][e] = (kk > r32) ? (_Float16)1.0f : (_Float16)0.0f; }
    f32x16 o[2];
#pragma unroll
    for (int r = 0; r < 16; ++r) { o[0][r] = 0.f; o[1][r] = 0.f; }
    float carry = 0.f;
    const int t = qw0 + r32;
    const int skey = lane >> 3, sc8 = lane & 7;
    const bf16_t* kg = Kh + (long)skey * PITCH + sc8 * 8; const bf16_t* vg = Vh + (long)skey * PITCH + sc8 * 8;
    LAS unsigned char* ksl = wl; LAS unsigned char* vsl = wl + 8192;
    int kw[2];
#pragma unroll
    for (int par = 0; par < 2; ++par) kw[par] = skey * 128 + ((sc8 ^ ((4 * par + (skey >> 1)) & 7)) << 4);
    const int vw = (sc8 >> 2) * 4096 + skey * 64 + (sc8 & 3) * 16;
    int koff[4];
#pragma unroll
    for (int d0 = 0; d0 < 4; ++d0) koff[d0] = r32 * 128 + (((2 * d0 + hi) ^ ((r32 >> 1) & 7)) << 4);
    const int vb = (int)(unsigned)(uintptr_t)vsl + ((lane >> 4) & 1) * 32 + (lane & 3) * 8 + (4 * hi + ((lane & 15) >> 2)) * 64;
    int kt = (qw0 + 30) >> 6;
    u32x4 kreg[8], vreg[8];
#pragma unroll
    for (int i = 0; i < 8; ++i) { kreg[i] = *(const u32x4*)(kg + (long)(kt * 64 + 8 * i) * PITCH); vreg[i] = *(const u32x4*)(vg + (long)(kt * 64 + 8 * i) * PITCH); }
    for (;;) {
#pragma unroll
        for (int i = 0; i < 8; ++i) { *(LAS u32x4*)(ksl + i * 1024 + kw[i & 1]) = kreg[i]; *(LAS u32x4*)(vsl + vw + (i >> 1) * 1024 + (i & 1) * 512) = vreg[i]; }
        const int ktn = kt > 0 ? kt - 1 : 0;
#pragma unroll
        for (int i = 0; i < 8; ++i) { kreg[i] = *(const u32x4*)(kg + (long)(ktn * 64 + 8 * i) * PITCH); vreg[i] = *(const u32x4*)(vg + (long)(ktn * 64 + 8 * i) * PITCH); }
        const int kbase = kt * 64;
        const u32x4 zz = (u32x4){0u, 0u, 0u, 0u};
        bf16x8 pa0 = __builtin_bit_cast(bf16x8, zz), pa1 = pa0, pa2 = pa0, pa3 = pa0;
        if (kbase + 32 < qw0 + 31) {
            if (kbase + 63 >= qw0) score_block<true>(ksl + 4096, koff, qr, tri, hi, t - (kbase + 32) - 4 * hi, carry, pa2, pa3);
            else score_block<false>(ksl + 4096, koff, qr, tri, hi, 0, carry, pa2, pa3);
        }
        if (!__all(carry < EXIT_THR)) {
            if (kbase + 31 >= qw0) score_block<true>(ksl, koff, qr, tri, hi, t - kbase - 4 * hi, carry, pa0, pa1);
            else score_block<false>(ksl, koff, qr, tri, hi, 0, carry, pa0, pa1);
        }
        pv(o, vb, pa0, pa1, pa2, pa3);
        if (kt == 0 || __all(carry < EXIT_THR)) break;
        --kt;
    }
    {
        LAS bf16_t* stg = (LAS bf16_t*)wl;
#pragma unroll
        for (int r = 0; r < 16; ++r) { const int orow = crow(r, hi);
#pragma unroll
            for (int d0 = 0; d0 < 2; ++d0) stg[orow * 64 + d0 * 32 + r32] = (bf16_t)(cvt_pk_bf16(o[d0][r], 0.f) & 0xffffu); }
        asm volatile("s_waitcnt lgkmcnt(0)" ::: "memory");
#pragma unroll
        for (int i = 0; i < 4; ++i) { const int row = i * 8 + (lane >> 3), ch = lane & 7; const u32x4 v = *(const LAS u32x4*)(stg + row * 64 + ch * 8); *(u32x4*)(Qw + (long)row * PITCH + ch * 8) = v; }
        asm volatile("s_waitcnt lgkmcnt(0)" ::: "memory");
    }
}
#undef SBAR
}


#define XB_TMO      128
#define XB_XCNT(j)  (256  + 64 * (j))
#define XB_XSUB(j)  (1280 + 64 * (j))
#define XB_XGEN(j)  (2304 + 64 * (j))
#define XB_TOP      3328
#define XB_TOPGEN   3392
#define XCD_BAR_WORDS 3456
#define XB_SPIN_CAP (1u << 22)
__device__ __forceinline__ unsigned xb_ld(unsigned* p)              { return __hip_atomic_load(p, __ATOMIC_RELAXED, __HIP_MEMORY_SCOPE_AGENT); }
__device__ __forceinline__ unsigned xb_add(unsigned* p, unsigned v) { return __hip_atomic_fetch_add(p, v, __ATOMIC_RELAXED, __HIP_MEMORY_SCOPE_AGENT); }
__device__ __forceinline__ unsigned xb_xcc_id() { return (unsigned)__builtin_amdgcn_s_getreg((3 << 11) | 20) & 0xFu; }
#define XB_SPIN(cond, bar) do { unsigned _sp = 0; while (cond) { __builtin_amdgcn_s_sleep(1); \
    if ((++_sp & 255u) == 0u) { if (xb_ld(&(bar)[XB_TMO])) break; if (_sp > XB_SPIN_CAP) { atomicAdd(&(bar)[XB_TMO], 1u); break; } } } } while (0)
struct XcdBarrier { unsigned* bar; unsigned x; volatile LAS unsigned* st; };
__device__ __forceinline__ XcdBarrier xcd_barrier_post(unsigned* bar, volatile LAS unsigned* st, int tid) {
    XcdBarrier b; b.bar = bar; b.x = xb_xcc_id(); b.st = st;
    if (tid == 0) (void)xb_add(&bar[XB_XCNT(b.x)], 1u);
    return b;
}
__device__ __forceinline__ void xcd_barrier_complete(unsigned* bar, unsigned x, unsigned& nloc, unsigned& nx) {
    const unsigned G = gridDim.x * gridDim.y * gridDim.z;
    unsigned sum, cnt, mine, sp = 0u;
    for (;;) {
        sum = 0u; cnt = 0u; mine = 0u;
#pragma unroll
        for (unsigned j = 0; j < 16; ++j) { const unsigned c = xb_ld(&bar[XB_XCNT(j)]); sum += c; cnt += (c > 0u) ? 1u : 0u; mine = (j == x) ? c : mine; }
        if (sum == G) break;
        __builtin_amdgcn_s_sleep(1);
        if ((++sp & 255u) == 0u) { if (xb_ld(&bar[XB_TMO])) break; if (sp > XB_SPIN_CAP) { atomicAdd(&bar[XB_TMO], 1u); break; } }
    }
    nloc = mine > 0u ? mine : 1u; nx = cnt > 0u ? cnt : 1u;
}
__device__ __forceinline__ void xcd_barrier(const XcdBarrier& b, int tid) {
    asm volatile("s_waitcnt vmcnt(0)" ::: "memory");
    __syncthreads();
    if (tid == 0) {
        unsigned* bar = b.bar;
        __builtin_amdgcn_s_waitcnt(0);
        unsigned nloc = b.st[0], nx = b.st[1];
        if (nloc == 0u) { xcd_barrier_complete(bar, b.x, nloc, nx); b.st[0] = nloc; b.st[1] = nx; }
        const unsigned old = xb_add(&bar[XB_XSUB(b.x)], 1u);
        const unsigned gen = old / nloc;
        if (old + 1u == (gen + 1u) * nloc) {
            __builtin_amdgcn_fence(__ATOMIC_RELEASE, "agent");
            asm volatile("s_waitcnt vmcnt(0)" ::: "memory");
            const unsigned og = xb_add(&bar[XB_TOP], 1u);
            const unsigned tg = og / nx;
            if (og + 1u == (tg + 1u) * nx) xb_add(&bar[XB_TOPGEN], 1u);
            else XB_SPIN(xb_ld(&bar[XB_TOPGEN]) == tg, bar);
            __builtin_amdgcn_fence(__ATOMIC_ACQUIRE, "agent");
            xb_add(&bar[XB_XGEN(b.x)], 1u);
            asm volatile("s_waitcnt vmcnt(0)" ::: "memory");
        } else {
            XB_SPIN(xb_ld(&bar[XB_XGEN(b.x)]) == gen, bar);
            __builtin_amdgcn_fence(__ATOMIC_ACQUIRE, "agent");
            asm volatile("s_waitcnt vmcnt(0)" ::: "memory");
        }
    }
    __syncthreads();
}

enum { T_MOD = 0, T_TRANS = 1, T_ROW = 2, T_GEMM = 3, T_ATTN = 4 };
struct PhaseDesc { const void* p[8]; int type, sync, i0, i1, i2, i3, i4, i5; };
constexpr int N_PHASES = 19;
struct Args { PhaseDesc ph[N_PHASES]; unsigned* bar; int ph_lo, ph_hi; int probe_mask, pad; };

__device__ __forceinline__ float wave_sum(float v) {
#pragma unroll
    for (int o = 1; o < 64; o <<= 1) v += __shfl_xor(v, o);
    return v;
}
__device__ __forceinline__ unsigned f2bf(float f) { unsigned u = __builtin_bit_cast(unsigned, f); return (u + 0x7fffu + ((u >> 16) & 1u)) >> 16; }
__device__ __forceinline__ unsigned pk2(float lo, float hi) { return f2bf(lo) | (f2bf(hi) << 16); }

struct TrItem { const float* src; bf16_t* dst; int N, K; };
__device__ __forceinline__ void tr_load(f32x4 (&v)[8], const TrItem& t, int lane) {
#pragma unroll
    for (int i = 0; i < 8; ++i) v[i] = *(const f32x4*)(t.src + (size_t)(8 * i + (lane >> 3)) * t.N + (lane & 7) * 4);
}
__device__ __forceinline__ void tr_store(const f32x4 (&v)[8], const TrItem& t, LAS float* scr, int lane) {
#pragma unroll
    for (int i = 0; i < 8; ++i) { LAS float* p = scr + (8 * i + (lane >> 3)) * 33 + (lane & 7) * 4; p[0] = v[i].x; p[1] = v[i].y; p[2] = v[i].z; p[3] = v[i].w; }
    asm volatile("s_waitcnt lgkmcnt(0)" ::: "memory");
    const int c = lane & 7;
#pragma unroll
    for (int j = 0; j < 4; ++j) { const int n = (lane >> 3) + 8 * j; const LAS float* s = scr + (8 * c) * 33 + n;
        u32x4 o; o.x = cvt_pk_bf16(s[0 * 33], s[1 * 33]); o.y = cvt_pk_bf16(s[2 * 33], s[3 * 33]); o.z = cvt_pk_bf16(s[4 * 33], s[5 * 33]); o.w = cvt_pk_bf16(s[6 * 33], s[7 * 33]);
        *(u32x4*)(t.dst + (size_t)n * t.K + 8 * c) = o; }
    asm volatile("s_waitcnt lgkmcnt(0)" ::: "memory");
}

constexpr int I_IN = (DM / 64) * (INC / 32), I_PC = (CWID / 64) * (DM / 32), I_OUT = (DM / 64) * (DM / 32), I_W1 = (DM / 64) * (FF / 32), I_W2 = (FF / 64) * (DM / 32);
constexpr int I_L = I_IN + 2 * I_PC + I_OUT + I_W1 + I_W2;
__device__ __forceinline__ TrItem tr_decode(const PhaseDesc& d, unsigned char* wbase, int pi, int half) {
    constexpr int P_L = I_L / 2;
    const int l = pi / P_L; int r = pi % P_L; unsigned char* wl = wbase + (size_t)l * WL_SZ;
    const float* W; bf16_t* WT; int N, Kd;
    if (r < I_IN / 2) { W = (const float*)d.p[0] + (size_t)l * DM * INC; N = INC; Kd = DM; WT = (bf16_t*)(wl + WL_IN); }
    else if ((r -= I_IN / 2) < I_PC / 2) { W = (const float*)d.p[1] + (size_t)l * CWID * DM; N = DM; Kd = CWID; WT = (bf16_t*)(wl + WL_PC); }
    else if ((r -= I_PC / 2) < I_PC / 2) { W = (const float*)d.p[2] + (size_t)l * CWID * DM; N = DM; Kd = CWID; WT = (bf16_t*)(wl + WL_PA); }
    else if ((r -= I_PC / 2) < I_OUT / 2) { W = (const float*)d.p[3] + (size_t)l * DM * DM; N = DM; Kd = DM; WT = (bf16_t*)(wl + WL_OUT); }
    else if ((r -= I_OUT / 2) < I_W1 / 2) { W = (const float*)d.p[4] + (size_t)l * DM * FF; N = FF; Kd = DM; WT = (bf16_t*)(wl + WL_W1); }
    else { r -= I_W1 / 2; W = (const float*)d.p[5] + (size_t)l * FF * DM; N = DM; Kd = FF; WT = (bf16_t*)(wl + WL_W2); }
    const int nblk = N / 32, kb = 2 * (r / nblk) + half, nb = r % nblk;
    TrItem t; t.src = W + (size_t)(64 * kb) * N + 32 * nb; t.dst = WT + (size_t)(32 * nb) * Kd + 64 * kb; t.N = N; t.K = Kd; return t;
}

template <bool XBF>
__device__ __forceinline__ void row_phase(int gw, int ngw, int lane, bool has_src, bool has_next, bool xout_bf, const bf16_t* src, const float* xin, float* xout,
                                          const float* g_post, const float* gate  , const float* g_pre, const float* shift, const float* scale, bf16_t* xn) {
    constexpr int XW = XBF ? 2 : 4;
    const int cb = 8 * lane;
    u32x4 xr[2][XW], sr[2][2];
    int m0 = gw, m1 = gw; bool pair = false;
    auto pick = [&](int mA, int& a, int& b, bool& pr) { a = mA; const int mB = mA + ngw; pr = (mB < MT) && ((mB >> 13) == (mA >> 13)); b = pr ? mB : mA; };
    auto load_raw = [&](u32x4 (&X)[2][XW], u32x4 (&S)[2][2], int a, int b) {
#pragma unroll
        for (int r = 0; r < 2; ++r) { const size_t m = (size_t)(r ? b : a);
#pragma unroll
            for (int j = 0; j < 2; ++j) {
                if (XBF) X[r][j] = *(const u32x4*)((const bf16_t*)xin + m * DM + cb + 512 * j);
                else { X[r][2 * j] = *(const u32x4*)(xin + m * DM + cb + 512 * j); X[r][2 * j + 1] = *(const u32x4*)(xin + m * DM + cb + 512 * j + 4); }
                if (has_src) S[r][j] = *(const u32x4*)(src + m * DM + cb + 512 * j); else S[r][j] = (u32x4){0u, 0u, 0u, 0u}; } }
    };
    if (gw >= MT) return;
    pick(gw, m0, m1, pair);
    load_raw(xr, sr, m0, m1);
    f32x4 gp[4], gt[4], gq[4], sh[4], sc[4]; int bcur = m0 >> 13;
#pragma unroll
    for (int jj = 0; jj < 4; ++jj) { const int c = cb + 512 * (jj >> 1) + 4 * (jj & 1);
        gp[jj] = *(const f32x4*)(g_post + c); gt[jj] = *(const f32x4*)(gate + (size_t)bcur * (NMOD * DM) + c);
        gq[jj] = *(const f32x4*)(g_pre + c); sh[jj] = *(const f32x4*)(shift + (size_t)bcur * (NMOD * DM) + c); sc[jj] = *(const f32x4*)(scale + (size_t)bcur * (NMOD * DM) + c); }
    for (;;) {
        const int mn = m0 + (pair ? 2 : 1) * ngw; const bool more = mn < MT;
        int n0, n1; bool npair; pick(more ? mn : m0, n0, n1, npair);
        u32x4 xq[2][XW], sq[2][2];
        load_raw(xq, sq, n0, n1);
        const int b = m0 >> 13;
        if (b != bcur) {
            bcur = b;
#pragma unroll
            for (int jj = 0; jj < 4; ++jj) { const int c = cb + 512 * (jj >> 1) + 4 * (jj & 1);
                gt[jj] = *(const f32x4*)(gate + (size_t)b * (NMOD * DM) + c); sh[jj] = *(const f32x4*)(shift + (size_t)b * (NMOD * DM) + c); sc[jj] = *(const f32x4*)(scale + (size_t)b * (NMOD * DM) + c); }
        }
        __builtin_amdgcn_sched_barrier(0);
        f32x4 x[2][4];
#pragma unroll
        for (int r = 0; r < 2; ++r)
#pragma unroll
            for (int j = 0; j < 2; ++j) {
                if (XBF) { const u32x4 w = xr[r][j]; x[r][2 * j] = (f32x4){bf_lo(w.x), bf_hi(w.x), bf_lo(w.y), bf_hi(w.y)}; x[r][2 * j + 1] = (f32x4){bf_lo(w.z), bf_hi(w.z), bf_lo(w.w), bf_hi(w.w)}; }
                else { x[r][2 * j] = __builtin_bit_cast(f32x4, xr[r][2 * j]); x[r][2 * j + 1] = __builtin_bit_cast(f32x4, xr[r][2 * j + 1]); } }
        if (has_src) {
            f32x4 s[2][4]; float ss[2];
#pragma unroll
            for (int r = 0; r < 2; ++r) { ss[r] = 0.f;
#pragma unroll
                for (int j = 0; j < 2; ++j) { const u32x4 w = sr[r][j]; s[r][2 * j] = (f32x4){bf_lo(w.x), bf_hi(w.x), bf_lo(w.y), bf_hi(w.y)}; s[r][2 * j + 1] = (f32x4){bf_lo(w.z), bf_hi(w.z), bf_lo(w.w), bf_hi(w.w)}; }
#pragma unroll
                for (int jj = 0; jj < 4; ++jj) ss[r] += (s[r][jj].x * s[r][jj].x + s[r][jj].y * s[r][jj].y) + (s[r][jj].z * s[r][jj].z + s[r][jj].w * s[r][jj].w); }
#pragma unroll
            for (int o = 1; o < 64; o <<= 1) { ss[0] += __shfl_xor(ss[0], o); ss[1] += __shfl_xor(ss[1], o); }
#pragma unroll
            for (int r = 0; r < 2; ++r) { const float rstd = __builtin_amdgcn_rsqf(ss[r] * (1.0f / DM) + EPS); const bool live = (r == 0) || pair; const size_t m = (size_t)(r ? m1 : m0);
#pragma unroll
                for (int jj = 0; jj < 4; ++jj) x[r][jj] = x[r][jj] + gt[jj] * (s[r][jj] * rstd * gp[jj]);
#pragma unroll
                for (int j = 0; j < 2; ++j) {
                    if (xout_bf) { u32x4 w; w.x = cvt_pk_bf16(x[r][2 * j].x, x[r][2 * j].y); w.y = cvt_pk_bf16(x[r][2 * j].z, x[r][2 * j].w); w.z = cvt_pk_bf16(x[r][2 * j + 1].x, x[r][2 * j + 1].y); w.w = cvt_pk_bf16(x[r][2 * j + 1].z, x[r][2 * j + 1].w);
                        if (live) st_wt16((bf16_t*)xout + m * DM + cb + 512 * j, w);
                        x[r][2 * j] = (f32x4){bf_lo(w.x), bf_hi(w.x), bf_lo(w.y), bf_hi(w.y)}; x[r][2 * j + 1] = (f32x4){bf_lo(w.z), bf_hi(w.z), bf_lo(w.w), bf_hi(w.w)}; }
                    else if (live) { st_wt16f(xout + m * DM + cb + 512 * j, x[r][2 * j]); st_wt16f(xout + m * DM + cb + 512 * j + 4, x[r][2 * j + 1]); } } }
        }
        if (has_next) {
            float ss[2];
#pragma unroll
            for (int r = 0; r < 2; ++r) { ss[r] = 0.f;
#pragma unroll
                for (int jj = 0; jj < 4; ++jj) ss[r] += (x[r][jj].x * x[r][jj].x + x[r][jj].y * x[r][jj].y) + (x[r][jj].z * x[r][jj].z + x[r][jj].w * x[r][jj].w); }
#pragma unroll
            for (int o = 1; o < 64; o <<= 1) { ss[0] += __shfl_xor(ss[0], o); ss[1] += __shfl_xor(ss[1], o); }
#pragma unroll
            for (int r = 0; r < 2; ++r) { const float rstd = __builtin_amdgcn_rsqf(ss[r] * (1.0f / DM) + EPS); const bool live = (r == 0) || pair; const size_t m = (size_t)(r ? m1 : m0);
#pragma unroll
                for (int j = 0; j < 2; ++j) { const f32x4 h0 = (x[r][2 * j] * rstd * gq[2 * j]) * (sc[2 * j] + 1.0f) + sh[2 * j], h1 = (x[r][2 * j + 1] * rstd * gq[2 * j + 1]) * (sc[2 * j + 1] + 1.0f) + sh[2 * j + 1];
                    u32x4 w; w.x = cvt_pk_bf16(h0.x, h0.y); w.y = cvt_pk_bf16(h0.z, h0.w); w.z = cvt_pk_bf16(h1.x, h1.y); w.w = cvt_pk_bf16(h1.z, h1.w);
                    if (live) st_wt16(xn + m * DM + cb + 512 * j, w); } }
        }
        if (!more) break;
#pragma unroll
        for (int r = 0; r < 2; ++r) {
#pragma unroll
            for (int j = 0; j < XW; ++j) xr[r][j] = xq[r][j];
            sr[r][0] = sq[r][0]; sr[r][1] = sq[r][1]; }
        m0 = n0; m1 = n1; pair = npair;
    }
}

constexpr int LDS_TOTAL = 131072 + 1024;

__global__ void __launch_bounds__(512, 2) mega_fwd(Args args) {
    __shared__ __attribute__((aligned(16))) unsigned char lds_raw[LDS_TOTAL];
    LAS unsigned char* lds = (LAS unsigned char*)lds_raw;
    volatile LAS unsigned* MISC = (volatile LAS unsigned*)(lds + 131072 + 512);
    if (threadIdx.x < 4) MISC[threadIdx.x] = 0u;
    __syncthreads();
    XcdBarrier xbar = xcd_barrier_post(args.bar, MISC, (int)threadIdx.x);
    unsigned long long probe_acc = 0ull;
    for (int ph = args.ph_lo; ph < args.ph_hi; ++ph) {
        int tid = threadIdx.x; asm volatile("" : "+v"(tid));
        const int lane = tid & 63; const int wave = __builtin_amdgcn_readfirstlane(tid >> 6);
        const int G = gridDim.x, bx = blockIdx.x;
        const int gw = bx * 8 + wave, ngw = G * 8;
        const PhaseDesc& d = args.ph[ph];
        const int type = d.type;
#if PROBE_TIMING
        const unsigned long long t_begin = __builtin_amdgcn_s_memrealtime();
#endif
        if (type == T_GEMM) {
            pg8::Gemm g{(const bf16_t*)d.p[0], (const bf16_t*)d.p[1], MT, d.i0, d.i1, d.i2, (d.i4 == 6) ? 1536 * 2 : 0, (d.i4 == 6) ? (int)(WL_PA - WL_PC) : 0};
            pg8::Epi E{(bf16_t*)d.p[2], d.i3, d.i4, (const bf16_t*)d.p[3], d.i5};
            pg8::StaticOrder S; S.init(MT, g.N, G, bx);
            pg8::gemm_phase(lds, g, S, E, tid);
        } else if (type == T_ATTN) {
            bf16_t* PROJ = (bf16_t*)d.p[0];
            for (int u = gw; u < 16 * 256; u += ngw) { const int bh = u >> 8, qblk = u & 255; att::attn_wave_unit(bh >> 3, bh & 7, qblk, PROJ, lds + wave * 16384, lane); }
            const float* cw = (const float*)d.p[1];
            const int ch = lane * 8;
            float w0[8], w1[8], w2[8];
#pragma unroll
            for (int i = 0; i < 8; ++i) { w0[i] = cw[ch + i]; w1[i] = cw[CWID + ch + i]; w2[i] = cw[2 * CWID + ch + i]; }
            for (int chunk = gw; chunk < MT / 8; chunk += ngw) {
                const int m0 = chunk * 8; const int tpos = m0 & (SEQ - 1);
                const int mlo = (tpos >= 2) ? m0 - 2 : m0;
                u32x4 cc[10], uu[10], bb[8];
#pragma unroll
                for (int i = 0; i < 2; ++i) { cc[i] = *(const u32x4*)(PROJ + (size_t)(mlo + i) * INC + 512 + ch); uu[i] = *(const u32x4*)(PROJ + (size_t)(mlo + i) * INC + 1024 + ch); }
#pragma unroll
                for (int i = 0; i < 8; ++i) { const size_t m = (size_t)(m0 + i); cc[2 + i] = *(const u32x4*)(PROJ + m * INC + 512 + ch); uu[2 + i] = *(const u32x4*)(PROJ + m * INC + 1024 + ch); bb[i] = *(const u32x4*)(PROJ + m * INC + ch); }
                float v2[8], v1[8];
                const float hz = (tpos >= 2) ? 1.f : 0.f;
#pragma unroll
                for (int i = 0; i < 4; ++i) { v2[2 * i] = hz * bf_lo(cc[0][i]) * bf_lo(uu[0][i]); v2[2 * i + 1] = hz * bf_hi(cc[0][i]) * bf_hi(uu[0][i]); v1[2 * i] = hz * bf_lo(cc[1][i]) * bf_lo(uu[1][i]); v1[2 * i + 1] = hz * bf_hi(cc[1][i]) * bf_hi(uu[1][i]); }
#pragma unroll
                for (int i8 = 0; i8 < 8; ++i8) {
                    const size_t m = (size_t)(m0 + i8);
                    float v0[8], y[8];
#pragma unroll
                    for (int i = 0; i < 4; ++i) { v0[2 * i] = bf_lo(cc[2 + i8][i]) * bf_lo(uu[2 + i8][i]); v0[2 * i + 1] = bf_hi(cc[2 + i8][i]) * bf_hi(uu[2 + i8][i]); }
#pragma unroll
                    for (int i = 0; i < 8; ++i) y[i] = w0[i] * v2[i] + w1[i] * v1[i] + w2[i] * v0[i];
                    u32x4 o;
#pragma unroll
                    for (int i = 0; i < 4; ++i) o[i] = cvt_pk_bf16(bf_lo(bb[i8][i]) * y[2 * i], bf_hi(bb[i8][i]) * y[2 * i + 1]);
                    *(u32x4*)(PROJ + m * INC + ch) = o;
#pragma unroll
                    for (int i = 0; i < 8; ++i) { v2[i] = v1[i]; v1[i] = v0[i]; }
                }
            }
        } else if (type == T_ROW) {
            if (d.i4 != 0) row_phase<true>(gw, ngw, lane, d.i0 != 0, d.i1 != 0, d.i5 != 0, (const bf16_t*)d.p[0], (const float*)d.p[1], (float*)d.p[2], (const float*)d.p[3], (const float*)d.p[4],
                      (const float*)d.p[5], (const float*)d.p[6], (const float*)d.p[6] + DM, (bf16_t*)d.p[7]);
            else row_phase<false>(gw, ngw, lane, d.i0 != 0, d.i1 != 0, d.i5 != 0, (const bf16_t*)d.p[0], (const float*)d.p[1], (float*)d.p[2], (const float*)d.p[3], (const float*)d.p[4],
                      (const float*)d.p[5], (const float*)d.p[6], (const float*)d.p[6] + DM, (bf16_t*)d.p[7]);
        } else if (type == T_MOD) {
            const float* w_ada = (const float*)d.p[0]; const float* b_ada = (const float*)d.p[1]; float* MOD = (float*)d.p[2]; const float* cvec = (const float*)d.p[3];
            for (int it = bx; it < 256; it += G) {
                const int l = it >> 7, n0 = (it & 127) * 48, ln = lane < 48 ? lane : 47;
                float a0 = 0.f, a1 = 0.f;
                const float* wp = w_ada + ((size_t)l * DM + wave * 128) * (NMOD * DM) + n0 + ln;
                const float* c0p = cvec + wave * 128; const float* c1p = cvec + DM + wave * 128;
                float cr[2][2];
                cr[0][0] = c0p[lane]; cr[0][1] = c0p[64 + lane]; cr[1][0] = c1p[lane]; cr[1][1] = c1p[64 + lane];
#pragma unroll
                for (int kb = 0; kb < 128; kb += 32) {
                    float wv[32];
#pragma unroll
                    for (int j = 0; j < 32; ++j) wv[j] = wp[(size_t)(kb + j) * (NMOD * DM)];
                    __builtin_amdgcn_sched_barrier(0);
#pragma unroll
                    for (int j = 0; j < 32; ++j) { const int k = kb + j;
                        const float c0 = __builtin_bit_cast(float, __builtin_amdgcn_readlane(__builtin_bit_cast(int, cr[0][k >> 6]), k & 63));
                        const float c1 = __builtin_bit_cast(float, __builtin_amdgcn_readlane(__builtin_bit_cast(int, cr[1][k >> 6]), k & 63));
                        a0 += wv[j] * c0; a1 += wv[j] * c1; }
                }
                LAS float* red = (LAS float*)lds;
                if (lane < 48) { red[(wave * 2 + 0) * 48 + lane] = a0; red[(wave * 2 + 1) * 48 + lane] = a1; }
                __syncthreads();
                if (tid < 96) { const int b = tid / 48, col = tid % 48; float s = b_ada[(size_t)l * (NMOD * DM) + n0 + col];
#pragma unroll
                    for (int w = 0; w < 8; ++w) s += red[(w * 2 + b) * 48 + col];
                    MOD[((size_t)l * 2 + b) * (NMOD * DM) + n0 + col] = s; }
                __syncthreads();
            }
        } else {
            LAS float* scr = (LAS float*)(lds + wave * 16384);
            unsigned char* wbase = (unsigned char*)d.p[6];
            for (int pi = gw; pi < I_L; pi += ngw) {
                f32x4 va[8], vb[8];
                const TrItem ta = tr_decode(d, wbase, pi, 0); tr_load(va, ta, lane);
                const TrItem tb = tr_decode(d, wbase, pi, 1); tr_load(vb, tb, lane);
                tr_store(va, ta, scr, lane);
                tr_store(vb, tb, scr, lane);
            }
        }
#if PROBE_TIMING
        if ((args.probe_mask >> type) & 1) probe_acc += __builtin_amdgcn_s_memrealtime() - t_begin;
        const unsigned long long t_sync = __builtin_amdgcn_s_memrealtime();
#endif
        if (ph + 1 < args.ph_hi) {
            if (d.sync == 2) cg::this_grid().sync();
            else if (d.sync == 1) xcd_barrier(xbar, tid);
        }
#if PROBE_TIMING
        if ((args.probe_mask >> 8) & 1) probe_acc += __builtin_amdgcn_s_memrealtime() - t_sync;
#endif
    }
#if PROBE_TIMING
    { const unsigned long long t0 = __builtin_amdgcn_s_memrealtime(); while (__builtin_amdgcn_s_memrealtime() - t0 < probe_acc) __builtin_amdgcn_s_sleep(8); }
#endif
}

static void build_phases(Args& a, void* const* d_in, void* d_out, void* d_ws) {
    unsigned char* ws = (unsigned char*)d_ws;
    float* MOD = (float*)(ws + WS_MOD); bf16_t* XN = (bf16_t*)(ws + WS_XN); bf16_t* PROJ = (bf16_t*)(ws + WS_PROJ);
    const float* x_in = (const float*)d_in[0];
    const float* g_pre_mix = (const float*)d_in[4]; const float* g_post_mix = (const float*)d_in[5]; const float* g_pre_mlp = (const float*)d_in[6]; const float* g_post_mlp = (const float*)d_in[7];
    float* out = (float*)d_out;
    float* XB0 = (float*)d_out;
    float* XT = (float*)(ws + WS_PROJ + 128 * MiB);
    int n = 0;
    auto add = [&](int type, int sync) -> PhaseDesc& { PhaseDesc& d = a.ph[n++]; d.type = type; d.sync = sync; return d; };
    { PhaseDesc& d = add(T_MOD, 0); d.p[0] = d_in[2]; d.p[1] = d_in[3]; d.p[2] = MOD; d.p[3] = d_in[1]; }
    { PhaseDesc& d = add(T_TRANS, 1); d.p[0] = d_in[8]; d.p[1] = d_in[10]; d.p[2] = d_in[11]; d.p[3] = d_in[12]; d.p[4] = d_in[13]; d.p[5] = d_in[14]; d.p[6] = ws + WS_W; }
    { PhaseDesc& d = add(T_ROW, 1); d.i0 = 0; d.i1 = 1; d.p[0] = XN; d.p[1] = x_in; d.p[2] = out; d.p[3] = g_pre_mix; d.p[4] = MOD; d.p[5] = g_pre_mix; d.p[6] = MOD + 0 * DM; d.p[7] = XN; }
    for (int l = 0; l < 2; ++l) {
        const unsigned char* wl = ws + WS_W + (size_t)l * WL_SZ;
        const float* modl = MOD + (size_t)l * 2 * (NMOD * DM);
        auto gemm = [&](const bf16_t* A, const void* Bt, int N, int K, int lda, bf16_t* O, int ldc, int mode, const bf16_t* Gt, int ldg, int sync) {
            PhaseDesc& d = add(T_GEMM, sync); d.p[0] = A; d.p[1] = Bt; d.p[2] = O; d.p[3] = Gt ? Gt : O; d.i0 = N; d.i1 = K; d.i2 = lda; d.i3 = ldc; d.i4 = mode; d.i5 = ldg; };
        gemm(XN, wl + WL_IN, INC, DM, DM, PROJ, INC, 1, nullptr, 0, 1);
        { PhaseDesc& d = add(T_ATTN, 1); d.p[0] = PROJ; d.p[1] = (const float*)d_in[9] + (size_t)l * 3 * CWID; }
        gemm(PROJ, wl + WL_PC, DM, CWID, INC, XN, DM, 6, PROJ + 4096, INC, 1);
        gemm(XN, wl + WL_OUT, DM, DM, DM, PROJ, DM, 0, nullptr, 0, 1);
        { PhaseDesc& d = add(T_ROW, 1); d.i0 = 1; d.i1 = 1; d.p[0] = PROJ; d.p[1] = (l == 0) ? x_in : XB0; d.p[2] = (l == 0) ? XB0 : XT; d.i4 = (l == 0) ? 0 : 1; d.i5 = 1; d.p[3] = g_post_mix + (size_t)l * DM; d.p[4] = modl + 2 * DM;
          d.p[5] = g_pre_mlp + (size_t)l * DM; d.p[6] = modl + 3 * DM; d.p[7] = XN; }
        gemm(XN, wl + WL_W1, FF, DM, DM, PROJ, FF, 2, nullptr, 0, 1);
        gemm(PROJ, wl + WL_W2, DM, FF, FF, XN, DM, 0, nullptr, 0, 1);
        { const int ln = (l + 1 < 2) ? l + 1 : l; const float* modn = MOD + (size_t)ln * 2 * (NMOD * DM);
          PhaseDesc& d = add(T_ROW, 1); d.i0 = 1; d.i1 = (l == 0) ? 1 : 0; d.p[0] = XN; d.p[1] = (l == 0) ? XB0 : XT; d.p[2] = (l == 0) ? XB0 : out; d.i4 = 1; d.i5 = (l == 0) ? 1 : 0; d.p[3] = g_post_mlp + (size_t)l * DM; d.p[4] = modl + 5 * DM;
          d.p[5] = g_pre_mix + (size_t)ln * DM; d.p[6] = modn + 0 * DM; d.p[7] = XN; }
    }
    if (n != N_PHASES) fprintf(stderr, "phase count mismatch: %d vs %d\n", n, N_PHASES);
}

extern "C" void kernel_launch(void* const* d_in, const int* in_sizes, int n_in, void* d_out, int out_size, void* d_ws, size_t ws_size, hipStream_t stream) {
    static int grid = 0;
    if (grid == 0) {
        int dev = 0, cus = 0, per_cu = 0;
        (void)hipGetDevice(&dev);
        (void)hipDeviceGetAttribute(&cus, hipDeviceAttributeMultiprocessorCount, dev);
        if (hipOccupancyMaxActiveBlocksPerMultiprocessor(&per_cu, (const void*)mega_fwd, 512, 0) != hipSuccess || per_cu < 1) per_cu = 1;
        (void)hipGetLastError();
        if (per_cu > 1) per_cu = 1;
        grid = cus * per_cu;
        if (ws_size < WS_END) fprintf(stderr, "kernel_launch: workspace too small: %zu < %zu\n", ws_size, (size_t)WS_END);
    }
    Args a{};
    build_phases(a, d_in, d_out, d_ws);
    a.bar = (unsigned*)((unsigned char*)d_ws + WS_BAR); a.probe_mask = PROBE_MASK;
    (void)hipMemsetAsync(a.bar, 0, XCD_BAR_WORDS * 4, stream);
#if MULTI_LAUNCH
    for (int ph = 0; ph < N_PHASES;) { int e = ph; while (!a.ph[e].sync) ++e; a.ph_lo = ph; a.ph_hi = e + 1; hipLaunchKernelGGL(mega_fwd, dim3(grid), dim3(512), 0, stream, a); ph = e + 1; }
#else
    a.ph_lo = 0; a.ph_hi = N_PHASES;
    void* kargs[] = {&a};
    hipError_t e = hipLaunchCooperativeKernel((const void*)mega_fwd, dim3(grid), dim3(512), kargs, 0, stream);
    if (e != hipSuccess) fprintf(stderr, "cooperative launch failed: %s (grid %d)\n", hipGetErrorString(e), grid);
#endif
}
```

```cpp
#include <hip/hip_runtime.h>
#include <hip/hip_cooperative_groups.h>
#include <cstdio>
#include <cstdint>
namespace cg = cooperative_groups;

#ifndef MULTI_LAUNCH
#define MULTI_LAUNCH 0
#endif
#ifndef PROBE_TIMING
#define PROBE_TIMING 0
#endif
#ifndef PROBE_MASK
#define PROBE_MASK 0
#endif

#define LAS __attribute__((address_space(3)))
typedef unsigned short bf16_t;
typedef short bf16x8 __attribute__((ext_vector_type(8)));
typedef _Float16 half8 __attribute__((ext_vector_type(8)));
typedef float f32x4 __attribute__((ext_vector_type(4)));
typedef float f32x2 __attribute__((ext_vector_type(2)));
typedef float f32x16 __attribute__((ext_vector_type(16)));
typedef unsigned u32x4 __attribute__((ext_vector_type(4)));
typedef unsigned u32x2 __attribute__((ext_vector_type(2)));
typedef short s16x4 __attribute__((ext_vector_type(4)));

constexpr int DM = 1024, SEQ = 8192, NB = 2, MT = NB * SEQ, INC = 5120, CWID = 512, FF = 4096, NMOD = 6;
constexpr float EPS = 1e-6f;
constexpr float LOG2E = 1.4426950408889634f;
constexpr float QSCALE = 0.125f * LOG2E;
constexpr float EXIT_THR = -150.0f;

constexpr size_t MiB = 1u << 20;
constexpr size_t WS_MOD = 0;
constexpr size_t WS_BAR = 1 * MiB;
constexpr size_t WS_W = 2 * MiB;
constexpr size_t WL_IN = 0, WL_PC = 10 * MiB, WL_PA = 11 * MiB, WL_OUT = 12 * MiB, WL_W1 = 14 * MiB, WL_W2 = 22 * MiB, WL_SZ = 30 * MiB;
constexpr size_t WS_XN = 62 * MiB;
constexpr size_t WS_PROJ = 94 * MiB;
constexpr size_t WS_END = 254 * MiB;

typedef __bf16 bf16x2_t __attribute__((ext_vector_type(2)));
__device__ __forceinline__ unsigned cvt_pk_bf16(float lo, float hi) { f32x2 v = {lo, hi}; bf16x2_t b = __builtin_convertvector(v, bf16x2_t); return __builtin_bit_cast(unsigned, b); }
__device__ __forceinline__ float bf_lo(unsigned w) { return __builtin_bit_cast(float, w << 16); }
__device__ __forceinline__ float bf_hi(unsigned w) { return __builtin_bit_cast(float, w & 0xffff0000u); }
__device__ __forceinline__ float fast_sigmoid(float v) { return __builtin_amdgcn_rcpf(1.0f + __builtin_amdgcn_exp2f(-v * LOG2E)); }

__device__ __forceinline__ void st_wt16(void* p, u32x4 v) { asm volatile("global_store_dwordx4 %0, %1, off sc1\n\ts_nop 1" :: "v"(p), "v"(v) : "memory"); }
__device__ __forceinline__ void st_wt16f(void* p, f32x4 v) { asm volatile("global_store_dwordx4 %0, %1, off sc1\n\ts_nop 1" :: "v"(p), "v"(v) : "memory"); }
__device__ __forceinline__ void st_wt8(void* p, u32x2 v) { asm volatile("global_store_dwordx2 %0, %1, off sc1\n\ts_nop 1" :: "v"(p), "v"(v) : "memory"); }

namespace pg8 {
constexpr int BM = 256, BK = 64, HALF = 128, HTB = HALF * BK * 2, STAGE_BYTES = 8 * HTB, NXCD = 8, WGM = 4;
__host__ __device__ __forceinline__ int lds_byte(int r, int c) { const int st = (r >> 4) * 2 + (c >> 5), rr = r & 15, cc = c & 31, ob = rr * 64 + cc * 2; return st * 1024 + (ob ^ (((ob >> 9) & 1) << 5)); }
__host__ __device__ __forceinline__ void stage_rc(int b, int& R, int& C) { const int st = b / 1024, sb = b % 1024, swz = sb ^ (((sb >> 9) & 1) << 5); R = (st >> 1) * 16 + swz / 64; C = (st & 1) * 32 + (swz % 64) / 2; }
__host__ __device__ __forceinline__ int perm32(int rho) { const int n = rho >> 4, i = rho & 15; return 8 * (i >> 2) + 4 * n + (i & 3); }
struct Unit { int pm, pn; };
struct Gemm { const bf16_t* A; const bf16_t* Bt; int M, N, K, lda; int a2, b2; };
struct StaticOrder {
    int nM, nN, nwg, G, c;
    __device__ void init(int M, int N, int G_, int c_) { nM = M / BM; nN = N / BM; nwg = nM * nN; G = G_; c = c_; }
    __device__ bool next(int i, Unit& u) const {
        const long L = (long)i * G + c; if (L >= nwg) return false;
        int wgid = (int)L; { const int q = nwg / NXCD, r = nwg % NXCD, xcd = wgid % NXCD, off = wgid / NXCD; wgid = (xcd < r ? xcd * (q + 1) : r * (q + 1) + (xcd - r) * q) + off; }
        const int nig = WGM * nN, gid = wgid / nig, fm = gid * WGM, gsz = (nM - fm) < WGM ? (nM - fm) : WGM;
        u.pm = fm + ((wgid % nig) % gsz); u.pn = (wgid % nig) / gsz; return true;
    }
};
constexpr float GB_TINY = 1e-30f;
struct Epi {
    bf16_t* O; int ldc; int mode; const bf16_t* Gt; int ldg;
    __device__ __forceinline__ void rescale(f32x4 (&acc)[2][2][4][2], const Unit& u, int wr, int wc, int fr, int fq) const {
        const int row0 = u.pm * BM + wr * 64 + fr; const int col0 = u.pn * BM + wc * 32 + 8 * fq;
#pragma unroll
        for (int ai = 0; ai < 2; ++ai) {
            u32x4 ga[4][2], gb[4][2];
#pragma unroll
            for (int m = 0; m < 4; ++m)
#pragma unroll
                for (int bj = 0; bj < 2; ++bj) { const bf16_t* gp = Gt + (size_t)(row0 + ai * HALF + m * 16) * ldg + col0 + bj * HALF; gb[m][bj] = *(const u32x4*)gp; ga[m][bj] = *(const u32x4*)(gp - 1024); }
            __builtin_amdgcn_sched_barrier(0);
#pragma unroll
            for (int m = 0; m < 4; ++m)
#pragma unroll
                for (int bj = 0; bj < 2; ++bj) { const u32x4 a = ga[m][bj], b = gb[m][bj];
#define PG8_RATIO(x, y) ((x) * __builtin_amdgcn_rcpf(fmaxf((y), GB_TINY)))
                    acc[ai][bj][m][0][0] *= PG8_RATIO(bf_lo(a.x), bf_lo(b.x)); acc[ai][bj][m][0][1] *= PG8_RATIO(bf_hi(a.x), bf_hi(b.x)); acc[ai][bj][m][0][2] *= PG8_RATIO(bf_lo(a.y), bf_lo(b.y)); acc[ai][bj][m][0][3] *= PG8_RATIO(bf_hi(a.y), bf_hi(b.y));
                    acc[ai][bj][m][1][0] *= PG8_RATIO(bf_lo(a.z), bf_lo(b.z)); acc[ai][bj][m][1][1] *= PG8_RATIO(bf_hi(a.z), bf_hi(b.z)); acc[ai][bj][m][1][2] *= PG8_RATIO(bf_lo(a.w), bf_lo(b.w)); acc[ai][bj][m][1][3] *= PG8_RATIO(bf_hi(a.w), bf_hi(b.w));
#undef PG8_RATIO
                }
        }
    }
    __device__ __forceinline__ void operator()(const f32x4 (&acc)[2][2][4][2], const Unit& u, int wr, int wc, int fr, int fq) const {
        const int row0 = u.pm * BM + wr * 64 + fr; const int col0 = u.pn * BM + wc * 32 + 8 * fq;
        int m1 = 0; float sc = 1.f;
        if (mode == 1) { if (u.pn >= 12) m1 = 1; else if (u.pn == 6 || u.pn == 7) sc = QSCALE; }
        if (mode == 6) {
#pragma unroll
            for (int ai = 0; ai < 2; ++ai) {
                u32x4 gv[4][2];
#pragma unroll
                for (int m = 0; m < 4; ++m)
#pragma unroll
                    for (int bj = 0; bj < 2; ++bj) gv[m][bj] = *(const u32x4*)(Gt + (size_t)(row0 + ai * HALF + m * 16) * ldg + col0 + bj * HALF);
                __builtin_amdgcn_sched_barrier(0);
#pragma unroll
                for (int m = 0; m < 4; ++m) {
                    bf16_t* rowp = O + (size_t)(row0 + ai * HALF + m * 16) * ldc + col0;
#pragma unroll
                    for (int bj = 0; bj < 2; ++bj) {
                        f32x4 v0 = acc[ai][bj][m][0], v1 = acc[ai][bj][m][1]; const u32x4 g = gv[m][bj];
                        v0[0] *= fmaxf(bf_lo(g.x), GB_TINY); v0[1] *= fmaxf(bf_hi(g.x), GB_TINY); v0[2] *= fmaxf(bf_lo(g.y), GB_TINY); v0[3] *= fmaxf(bf_hi(g.y), GB_TINY);
                        v1[0] *= fmaxf(bf_lo(g.z), GB_TINY); v1[1] *= fmaxf(bf_hi(g.z), GB_TINY); v1[2] *= fmaxf(bf_lo(g.w), GB_TINY); v1[3] *= fmaxf(bf_hi(g.w), GB_TINY);
                        u32x4 w; w.x = cvt_pk_bf16(v0[0], v0[1]); w.y = cvt_pk_bf16(v0[2], v0[3]); w.z = cvt_pk_bf16(v1[0], v1[1]); w.w = cvt_pk_bf16(v1[2], v1[3]);
                        st_wt16(rowp + bj * HALF, w);
                    }
                }
            }
            return;
        }
        if (mode >= 3) {
#pragma unroll
            for (int ai = 0; ai < 2; ++ai) {
                u32x4 gv[4][2], pv_[4][2];
#pragma unroll
                for (int m = 0; m < 4; ++m)
#pragma unroll
                    for (int bj = 0; bj < 2; ++bj) {
                        const size_t row = (size_t)(row0 + ai * HALF + m * 16);
                        gv[m][bj] = *(const u32x4*)(Gt + row * ldg + col0 + bj * HALF);
                        pv_[m][bj] = (mode == 4) ? *(const u32x4*)(O + row * ldc + col0 + bj * HALF) : (u32x4){0u, 0u, 0u, 0u};
                    }
                __builtin_amdgcn_sched_barrier(0);
#pragma unroll
                for (int m = 0; m < 4; ++m) {
                    const size_t row = (size_t)(row0 + ai * HALF + m * 16);
                    bf16_t* rowp = O + row * ldc + col0;
#pragma unroll
                    for (int bj = 0; bj < 2; ++bj) {
                        f32x4 v0 = acc[ai][bj][m][0], v1 = acc[ai][bj][m][1];
                        const u32x4 g = gv[m][bj], p = pv_[m][bj];
                        v0[0] = v0[0] * bf_lo(g.x) + bf_lo(p.x); v0[1] = v0[1] * bf_hi(g.x) + bf_hi(p.x); v0[2] = v0[2] * bf_lo(g.y) + bf_lo(p.y); v0[3] = v0[3] * bf_hi(g.y) + bf_hi(p.y);
                        v1[0] = v1[0] * bf_lo(g.z) + bf_lo(p.z); v1[1] = v1[1] * bf_hi(g.z) + bf_hi(p.z); v1[2] = v1[2] * bf_lo(g.w) + bf_lo(p.w); v1[3] = v1[3] * bf_hi(g.w) + bf_hi(p.w);
                        u32x4 w; w.x = cvt_pk_bf16(v0[0], v0[1]); w.y = cvt_pk_bf16(v0[2], v0[3]); w.z = cvt_pk_bf16(v1[0], v1[1]); w.w = cvt_pk_bf16(v1[2], v1[3]);
                        st_wt16(rowp + bj * HALF, w);
                    }
                }
            }
            return;
        }
#pragma unroll
        for (int ai = 0; ai < 2; ++ai)
#pragma unroll
            for (int m = 0; m < 4; ++m) {
                const size_t row = (size_t)(row0 + ai * HALF + m * 16);
                bf16_t* rowp = O + row * ldc + col0;
#pragma unroll
                for (int bj = 0; bj < 2; ++bj) {
                    f32x4 v0 = acc[ai][bj][m][0], v1 = acc[ai][bj][m][1];
                    if (mode == 1) {
                        if (m1) {
#pragma unroll
                            for (int i = 0; i < 4; ++i) { v0[i] = fast_sigmoid(v0[i]); v1[i] = fast_sigmoid(v1[i]); }
                        } else { v0 = v0 * sc; v1 = v1 * sc; }
                    } else if (mode == 2) {
#pragma unroll
                        for (int i = 0; i < 4; ++i) { const float a = fmaxf(v0[i], 0.f), b = fmaxf(v1[i], 0.f); v0[i] = a * a; v1[i] = b * b; }
                    } else if (mode >= 3) {
                        const u32x4 g = *(const u32x4*)(Gt + row * ldg + col0 + bj * HALF);
                        v0[0] *= bf_lo(g.x); v0[1] *= bf_hi(g.x); v0[2] *= bf_lo(g.y); v0[3] *= bf_hi(g.y);
                        v1[0] *= bf_lo(g.z); v1[1] *= bf_hi(g.z); v1[2] *= bf_lo(g.w); v1[3] *= bf_hi(g.w);
                        if (mode == 4) {
                            const u32x4 p = *(const u32x4*)(rowp + bj * HALF);
                            v0[0] += bf_lo(p.x); v0[1] += bf_hi(p.x); v0[2] += bf_lo(p.y); v0[3] += bf_hi(p.y);
                            v1[0] += bf_lo(p.z); v1[1] += bf_hi(p.z); v1[2] += bf_lo(p.w); v1[3] += bf_hi(p.w);
                        }
                    }
                    u32x4 w; w.x = cvt_pk_bf16(v0[0], v0[1]); w.y = cvt_pk_bf16(v0[2], v0[3]); w.z = cvt_pk_bf16(v1[0], v1[1]); w.w = cvt_pk_bf16(v1[2], v1[3]);
                    st_wt16(rowp + bj * HALF, w);
                }
            }
    }
};

__device__ __forceinline__ void gemm_phase(LAS unsigned char* lds, const Gemm g, const StaticOrder& S, const Epi& E, const int tid) {
    const int wid = __builtin_amdgcn_readfirstlane(tid >> 6), lane = tid & 63, wr = wid >> 2, wc = wid & 3, fr = lane & 15, fq = lane >> 4;
    const int K = g.K, nt = K / BK, lda = g.lda;
    unsigned voffA[2], voffB[2];
#pragma unroll
    for (int i = 0; i < 2; ++i) { int R, C; stage_rc(tid * 16 + i * 8192, R, C); const int Rb = (R & ~31) + perm32(R & 31);
        voffA[i] = (unsigned)(R * lda + C) * 2u; voffB[i] = (unsigned)(Rb * K + C) * 2u; }
    const size_t kstep = (size_t)(BK * 2);
    const size_t hstepA = (size_t)HALF * lda * 2, hstepB = (size_t)HALF * K * 2;
    const size_t tstepA = 2 * hstepA, tstepB = 2 * hstepB;
    const unsigned ldsw = (unsigned)wid * 1024u;
    const int aoff = lds_byte(wr * 64 + fr, fq * 8), boff = lds_byte(wc * 32 + fr, fq * 8);
#define PG8_SA(b, h) (((b) * 2 + (h)) * HTB)
#define PG8_SB(b, h) ((4 + (b) * 2 + (h)) * HTB)
#define PG8_STAGE(bufoff, gbase, voff) do { _Pragma("unroll") for (int _i = 0; _i < 2; ++_i) \
        __builtin_amdgcn_global_load_lds((const unsigned*)((const char*)(gbase) + (voff)[_i]), (LAS unsigned*)(lds + (bufoff) + ldsw + _i * 8192), 16, 0, 0); } while (0)
#define PG8_LDA(dst, b, h) do { _Pragma("unroll") for (int m = 0; m < 4; ++m) _Pragma("unroll") for (int k = 0; k < 2; ++k) dst[m][k] = *(const LAS bf16x8*)(lds + PG8_SA(b, h) + aoff + m * 2048 + k * 1024); } while (0)
#define PG8_LDB(dst, b, h) do { _Pragma("unroll") for (int n = 0; n < 2; ++n) _Pragma("unroll") for (int k = 0; k < 2; ++k) dst[n][k] = *(const LAS bf16x8*)(lds + PG8_SB(b, h) + boff + n * 2048 + k * 1024); } while (0)
#define PG8_MMA(ai, bj, At, Bt) do { __builtin_amdgcn_s_setprio(1); _Pragma("unroll") for (int m = 0; m < 4; ++m) _Pragma("unroll") for (int n = 0; n < 2; ++n) _Pragma("unroll") for (int k = 0; k < 2; ++k) \
        acc[ai][bj][m][n] = __builtin_amdgcn_mfma_f32_16x16x32_bf16(Bt[n][k], At[m][k], acc[ai][bj][m][n], 0, 0, 0); __builtin_amdgcn_s_setprio(0); } while (0)
#define PG8_WAIT_V(n) asm volatile("s_waitcnt vmcnt(" #n ")" ::: "memory")
#define PG8_WAIT_L(n) asm volatile("s_waitcnt lgkmcnt(" #n ")" ::: "memory")
#define PG8_BAR __builtin_amdgcn_s_barrier()
#define PG8_SCHED __builtin_amdgcn_sched_barrier(0)
    Unit cur, nxt; int ui = 0;
    const bool two = (g.a2 != 0);
    if (!S.next(0, cur)) return;
    f32x4 acc[2][2][4][2];
#pragma unroll
    for (int a = 0; a < 2; ++a)
#pragma unroll
        for (int b = 0; b < 2; ++b)
#pragma unroll
            for (int m = 0; m < 4; ++m)
#pragma unroll
                for (int n = 0; n < 2; ++n) acc[a][b][m][n] = (f32x4){0.f, 0.f, 0.f, 0.f};
    bf16x8 At[4][2], B0[2][2], B1[2][2];
    const char* cA = (const char*)g.A + (size_t)cur.pm * tstepA; const char* cB = (const char*)g.Bt + (size_t)cur.pn * tstepB;
    PG8_STAGE(PG8_SB(0, 0), cB, voffB); PG8_STAGE(PG8_SB(0, 1), cB + hstepB, voffB); PG8_STAGE(PG8_SA(0, 0), cA, voffA); PG8_STAGE(PG8_SA(0, 1), cA + hstepA, voffA);
    if (wr == 1) PG8_BAR;
    PG8_WAIT_V(2); PG8_BAR;
    PG8_STAGE(PG8_SB(1, 0), cB + kstep, voffB); PG8_STAGE(PG8_SA(1, 0), cA + kstep, voffA); PG8_STAGE(PG8_SB(1, 1), cB + hstepB + kstep, voffB);
    PG8_WAIT_V(6); PG8_BAR;
    for (;;) {
        const int nv = ui + 1, npass = two ? (nv & 1) : 0;
        const bool has_next = S.next(two ? (nv >> 1) : nv, nxt);
        const char* nA = has_next ? (const char*)g.A + (size_t)nxt.pm * tstepA + (size_t)npass * g.a2 : cA; const char* nB = has_next ? (const char*)g.Bt + (size_t)nxt.pn * tstepB + (size_t)npass * g.b2 : cB;
        for (int t = 0; t < nt; t += 2) {
            const bool last = (t == nt - 2);
            const char* a1 = cA + (size_t)(t + 1) * kstep;
            const char* a2 = last ? nA : cA + (size_t)(t + 2) * kstep; const char* b2 = last ? nB : cB + (size_t)(t + 2) * kstep;
            const char* a3 = a2 + kstep; const char* b3 = b2 + kstep;
            PG8_LDB(B0, 0, 0); PG8_LDB(B1, 0, 1); PG8_SCHED; PG8_LDA(At, 0, 0); PG8_STAGE(PG8_SA(1, 1), a1 + hstepA, voffA);
            PG8_WAIT_V(8); PG8_WAIT_L(0); PG8_BAR; PG8_MMA(0, 0, At, B0); PG8_MMA(0, 1, At, B1); PG8_BAR; PG8_SCHED;
            PG8_LDA(At, 0, 1); PG8_STAGE(PG8_SB(0, 0), b2, voffB); PG8_STAGE(PG8_SB(0, 1), b2 + hstepB, voffB); PG8_STAGE(PG8_SA(0, 0), a2, voffA);
            PG8_WAIT_V(8); PG8_WAIT_L(0); PG8_BAR; PG8_MMA(1, 0, At, B0); PG8_MMA(1, 1, At, B1); PG8_BAR; PG8_SCHED;
            PG8_LDB(B0, 1, 0); PG8_LDB(B1, 1, 1); PG8_SCHED; PG8_LDA(At, 1, 0); PG8_STAGE(PG8_SA(0, 1), a2 + hstepA, voffA);
            PG8_WAIT_V(8); PG8_WAIT_L(0); PG8_BAR; PG8_MMA(0, 0, At, B0); PG8_MMA(0, 1, At, B1); PG8_BAR; PG8_SCHED;
            PG8_LDA(At, 1, 1); PG8_STAGE(PG8_SB(1, 0), b3, voffB); PG8_STAGE(PG8_SB(1, 1), b3 + hstepB, voffB); PG8_STAGE(PG8_SA(1, 0), a3, voffA);
            PG8_WAIT_V(8); PG8_WAIT_L(0); PG8_BAR; PG8_MMA(1, 0, At, B0); PG8_MMA(1, 1, At, B1); PG8_BAR; PG8_SCHED;
        }
        if (wr == 0) PG8_BAR;
        const bool mid = two && ((ui & 1) == 0);
        if (mid) E.rescale(acc, cur, wr, wc, fr, fq); else E(acc, cur, wr, wc, fr, fq);
        if (!has_next) break;
#pragma unroll
        for (int a = 0; a < 2; ++a)
#pragma unroll
            for (int b = 0; b < 2; ++b)
#pragma unroll
                for (int m = 0; m < 4; ++m)
#pragma unroll
                    for (int n = 0; n < 2; ++n) acc[a][b][m][n] = mid ? acc[a][b][m][n] : (f32x4){0.f, 0.f, 0.f, 0.f};
        cur = nxt; cA = nA; cB = nB; ++ui;
        if (wr == 1) PG8_BAR;
    }
    PG8_WAIT_V(0);
    PG8_BAR;
#undef PG8_SA
#undef PG8_SB
#undef PG8_STAGE
#undef PG8_LDA
#undef PG8_LDB
#undef PG8_MMA
#undef PG8_WAIT_V
#undef PG8_WAIT_L
#undef PG8_BAR
#undef PG8_SCHED
}
}

namespace att {
constexpr int PITCH = INC;
constexpr int LDS_K = 0, LDS_V = 8192, LDS_FLAG = 16384, LDS_OST = 32768;
__device__ __forceinline__ int crow(int r, int hi) { return (r & 3) + 8 * (r >> 2) + 4 * hi; }
#define SBAR() __builtin_amdgcn_sched_barrier(0)
__device__ __forceinline__ void pv(f32x16* o, int vb, bf16x8 pa0, bf16x8 pa1, bf16x8 pa2, bf16x8 pa3) {
#pragma unroll
    for (int d0 = 0; d0 < 2; ++d0) { s16x4 lo[4], hi[4];
#pragma unroll
        for (int ks = 0; ks < 4; ++ks) {
            asm volatile("ds_read_b64_tr_b16 %0,%1 offset:%c2" : "=&v"(lo[ks]) : "v"(vb), "i"(d0 * 4096 + ks * 1024) : "memory");
            asm volatile("ds_read_b64_tr_b16 %0,%1 offset:%c2" : "=&v"(hi[ks]) : "v"(vb), "i"(d0 * 4096 + ks * 1024 + 512) : "memory"); }
        asm volatile("s_waitcnt lgkmcnt(0)" ::: "memory"); SBAR();
#define PK(k) (bf16x8){lo[k][0], lo[k][1], lo[k][2], lo[k][3], hi[k][0], hi[k][1], hi[k][2], hi[k][3]}
        o[d0] = __builtin_amdgcn_mfma_f32_32x32x16_bf16(pa0, PK(0), o[d0], 0, 0, 0);
        o[d0] = __builtin_amdgcn_mfma_f32_32x32x16_bf16(pa1, PK(1), o[d0], 0, 0, 0);
        o[d0] = __builtin_amdgcn_mfma_f32_32x32x16_bf16(pa2, PK(2), o[d0], 0, 0, 0);
        o[d0] = __builtin_amdgcn_mfma_f32_32x32x16_bf16(pa3, PK(3), o[d0], 0, 0, 0);
#undef PK
    }
}
__device__ __forceinline__ float bcast_lo(float v) {
    auto rr = __builtin_amdgcn_permlane32_swap(__builtin_bit_cast(unsigned, v), __builtin_bit_cast(unsigned, v), false, false);
    return __builtin_bit_cast(float, rr[0]);
}
typedef _Float16 half2v __attribute__((ext_vector_type(2)));
template <bool MASK>
__device__ __forceinline__ void score_block(const LAS unsigned char* Kblk  , const int (&koff)[4], const bf16x8 (&qr)[4], const half8 (&tri)[2], int hi, int lim  , float& carry, bf16x8& pa_lo, bf16x8& pa_hi) {
    f32x16 z;
#pragma unroll
    for (int r = 0; r < 16; ++r) z[r] = 0.f;
#pragma unroll
    for (int d0 = 0; d0 < 4; ++d0) {
        const bf16x8 kf = *(const LAS bf16x8*)(Kblk + koff[d0]);
        z = __builtin_amdgcn_mfma_f32_32x32x16_bf16(kf, qr[d0], z, 0, 0, 0);
    }
    const f32x2 cc = (f32x2){carry, carry};
    f32x2 lsc[8]; half2v lh[8]; float nsp0 = 0.f;
#pragma unroll
    for (int p = 0; p < 8; ++p) {
        const f32x2 zp = (f32x2){z[2 * p], z[2 * p + 1]};
        f32x2 e; e.x = __builtin_amdgcn_exp2f(-__builtin_fabsf(zp.x)); e.y = __builtin_amdgcn_exp2f(-__builtin_fabsf(zp.y));
        const f32x2 tt = e + 1.0f;
        f32x2 lg; lg.x = __builtin_amdgcn_logf(tt.x); lg.y = __builtin_amdgcn_logf(tt.y);
        f32x2 mx; mx.x = fmaxf(zp.x, 0.f); mx.y = fmaxf(zp.y, 0.f);
        f32x2 nsp = (-mx) - lg;
        f32x2 ls = zp + nsp;
        if (MASK) {
            const int c0 = ((2 * p) & 3) + 8 * ((2 * p) >> 2);
            const bool v0 = c0 < lim, v1 = (c0 + 1) < lim;
            nsp.x = v0 ? nsp.x : 0.f; nsp.y = v1 ? nsp.y : 0.f;
            ls.x = v0 ? ls.x : -INFINITY; ls.y = v1 ? ls.y : -INFINITY;
        }
        if (p == 0) nsp0 = nsp.x;
        lh[p] = __builtin_convertvector(nsp, half2v);
        lsc[p] = ls + cc;
    }
    half8 lf0, lf1;
#pragma unroll
    for (int p = 0; p < 4; ++p) { lf0[2 * p] = lh[p].x; lf0[2 * p + 1] = lh[p].y; lf1[2 * p] = lh[4 + p].x; lf1[2 * p + 1] = lh[4 + p].y; }
    f32x16 y;
#pragma unroll
    for (int r = 0; r < 16; ++r) y[r] = 0.f;
    y = __builtin_amdgcn_mfma_f32_32x32x16_f16(tri[0], lf0, y, 0, 0, 0);
    y = __builtin_amdgcn_mfma_f32_32x32x16_f16(tri[1], lf1, y, 0, 0, 0);
    unsigned w[8];
#pragma unroll
    for (int p = 0; p < 8; ++p) { const f32x2 ar = lsc[p] + (f32x2){y[2 * p], y[2 * p + 1]}; w[p] = cvt_pk_bf16(__builtin_amdgcn_exp2f(ar.x), __builtin_amdgcn_exp2f(ar.y)); }
    carry = bcast_lo(carry + y[0] + nsp0);
    pa_lo = __builtin_bit_cast(bf16x8, (u32x4){w[0], w[1], w[2], w[3]}); pa_hi = __builtin_bit_cast(bf16x8, (u32x4){w[4], w[5], w[6], w[7]});
}

__device__ __forceinline__ void attn_wave_unit(int b, int h, int qblk, bf16_t* PROJ, LAS unsigned char* wl, const int lane) {
    const int r32 = lane & 31, hi = lane >> 5;
    const long rowbase = (long)b * SEQ; const int qw0 = qblk * 32;
    bf16_t* Qw = PROJ + (rowbase + qw0) * PITCH + 1536 + h * 64;
    const bf16_t* Kh = PROJ + rowbase * PITCH + 2048 + h * 64; const bf16_t* Vh = PROJ + rowbase * PITCH + 2560 + h * 64;
    bf16x8 qr[4];
#pragma unroll
    for (int d0 = 0; d0 < 4; ++d0) qr[d0] = *(const bf16x8*)(Qw + (long)r32 * PITCH + d0 * 16 + hi * 8);
    half8 tri[2];
#pragma unroll
    for (int s = 0; s < 2; ++s)
#pragma unroll
        for (int e = 0; e < 8; ++e) { const int kk = 16 * s + 8 * (e >> 2) + 4 * hi + (e & 3); tri[s][e] = (kk > r32) ? (_Float16)1.0f : (_Float16)0.0f; }
    f32x16 o[2];
#pragma unroll
    for (int r = 0; r < 16; ++r) { o[0][r] = 0.f; o[1][r] = 0.f; }
    float carry = 0.f;
    const int t = qw0 + r32;
    const int skey = lane >> 3, sc8 = lane & 7;
    const bf16_t* kg = Kh + (long)skey * PITCH + sc8 * 8; const bf16_t* vg = Vh + (long)skey * PITCH + sc8 * 8;
    LAS unsigned char* ksl = wl; LAS unsigned char* vsl = wl + 8192;
    int kw[2];
#pragma unroll
    for (int par = 0; par < 2; ++par) kw[par] = skey * 128 + ((sc8 ^ ((4 * par + (skey >> 1)) & 7)) << 4);
    const int vw = (sc8 >> 2) * 4096 + skey * 64 + (sc8 & 3) * 16;
    int koff[4];
#pragma unroll
    for (int d0 = 0; d0 < 4; ++d0) koff[d0] = r32 * 128 + (((2 * d0 + hi) ^ ((r32 >> 1) & 7)) << 4);
    const int vb = (int)(unsigned)(uintptr_t)vsl + ((lane >> 4) & 1) * 32 + (lane & 3) * 8 + (4 * hi + ((lane & 15) >> 2)) * 64;
    int kt = (qw0 + 30) >> 6;
    u32x4 kreg[8], vreg[8];
#pragma unroll
    for (int i = 0; i < 8; ++i) { kreg[i] = *(const u32x4*)(kg + (long)(kt * 64 + 8 * i) * PITCH); vreg[i] = *(const u32x4*)(vg + (long)(kt * 64 + 8 * i) * PITCH); }
    for (;;) {
#pragma unroll
        for (int i = 0; i < 8; ++i) { *(LAS u32x4*)(ksl + i * 1024 + kw[i & 1]) = kreg[i]; *(LAS u32x4*)(vsl + vw + (i >> 1) * 1024 + (i & 1) * 512) = vreg[i]; }
        const int ktn = kt > 0 ? kt - 1 : 0;
#pragma unroll
        for (int i = 0; i < 8; ++i) { kreg[i] = *(const u32x4*)(kg + (long)(ktn * 64 + 8 * i) * PITCH); vreg[i] = *(const u32x4*)(vg + (long)(ktn * 64 + 8 * i) * PITCH); }
        const int kbase = kt * 64;
        const u32x4 zz = (u32x4){0u, 0u, 0u, 0u};
        bf16x8 pa0 = __builtin_bit_cast(bf16x8, zz), pa1 = pa0, pa2 = pa0, pa3 = pa0;
        if (kbase + 32 < qw0 + 31) {
            if (kbase + 63 >= qw0) score_block<true>(ksl + 4096, koff, qr, tri, hi, t - (kbase + 32) - 4 * hi, carry, pa2, pa3);
            else score_block<false>(ksl + 4096, koff, qr, tri, hi, 0, carry, pa2, pa3);
        }
        if (!__all(carry < EXIT_THR)) {
            if (kbase + 31 >= qw0) score_block<true>(ksl, koff, qr, tri, hi, t - kbase - 4 * hi, carry, pa0, pa1);
            else score_block<false>(ksl, koff, qr, tri, hi, 0, carry, pa0, pa1);
        }
        pv(o, vb, pa0, pa1, pa2, pa3);
        if (kt == 0 || __all(carry < EXIT_THR)) break;
        --kt;
    }
    {
        LAS bf16_t* stg = (LAS bf16_t*)wl;
#pragma unroll
        for (int r = 0; r < 16; ++r) { const int orow = crow(r, hi);
#pragma unroll
            for (int d0 = 0; d0 < 2; ++d0) stg[orow * 64 + d0 * 32 + r32] = (bf16_t)(cvt_pk_bf16(o[d0][r], 0.f) & 0xffffu); }
        asm volatile("s_waitcnt lgkmcnt(0)" ::: "memory");
#pragma unroll
        for (int i = 0; i < 4; ++i) { const int row = i * 8 + (lane >> 3), ch = lane & 7; const u32x4 v = *(const LAS u32x4*)(stg + row * 64 + ch * 8); *(u32x4*)(Qw + (long)row * PITCH + ch * 8) = v; }
        asm volatile("s_waitcnt lgkmcnt(0)" ::: "memory");
    }
}
#undef SBAR
}


#define XB_TMO      128
#define XB_XCNT(j)  (256  + 64 * (j))
#define XB_XSUB(j)  (1280 + 64 * (j))
#define XB_XGEN(j)  (2304 + 64 * (j))
#define XB_TOP      3328
#define XB_TOPGEN   3392
#define XCD_BAR_WORDS 3456
#define XB_SPIN_CAP (1u << 22)
__device__ __forceinline__ unsigned xb_ld(unsigned* p)              { return __hip_atomic_load(p, __ATOMIC_RELAXED, __HIP_MEMORY_SCOPE_AGENT); }
__device__ __forceinline__ unsigned xb_add(unsigned* p, unsigned v) { return __hip_atomic_fetch_add(p, v, __ATOMIC_RELAXED, __HIP_MEMORY_SCOPE_AGENT); }
__device__ __forceinline__ unsigned xb_xcc_id() { return (unsigned)__builtin_amdgcn_s_getreg((3 << 11) | 20) & 0xFu; }
#define XB_SPIN(cond, bar) do { unsigned _sp = 0; while (cond) { __builtin_amdgcn_s_sleep(1); \
    if ((++_sp & 255u) == 0u) { if (xb_ld(&(bar)[XB_TMO])) break; if (_sp > XB_SPIN_CAP) { atomicAdd(&(bar)[XB_TMO], 1u); break; } } } } while (0)
struct XcdBarrier { unsigned* bar; unsigned x; volatile LAS unsigned* st; };
__device__ __forceinline__ XcdBarrier xcd_barrier_post(unsigned* bar, volatile LAS unsigned* st, int tid) {
    XcdBarrier b; b.bar = bar; b.x = xb_xcc_id(); b.st = st;
    if (tid == 0) (void)xb_add(&bar[XB_XCNT(b.x)], 1u);
    return b;
}
__device__ __forceinline__ void xcd_barrier_complete(unsigned* bar, unsigned x, unsigned& nloc, unsigned& nx) {
    const unsigned G = gridDim.x * gridDim.y * gridDim.z;
    unsigned sum, cnt, mine, sp = 0u;
    for (;;) {
        sum = 0u; cnt = 0u; mine = 0u;
#pragma unroll
        for (unsigned j = 0; j < 16; ++j) { const unsigned c = xb_ld(&bar[XB_XCNT(j)]); sum += c; cnt += (c > 0u) ? 1u : 0u; mine = (j == x) ? c : mine; }
        if (sum == G) break;
        __builtin_amdgcn_s_sleep(1);
        if ((++sp & 255u) == 0u) { if (xb_ld(&bar[XB_TMO])) break; if (sp > XB_SPIN_CAP) { atomicAdd(&bar[XB_TMO], 1u); break; } }
    }
    nloc = mine > 0u ? mine : 1u; nx = cnt > 0u ? cnt : 1u;
}
__device__ __forceinline__ void xcd_barrier(const XcdBarrier& b, int tid) {
    asm volatile("s_waitcnt vmcnt(0)" ::: "memory");
    __syncthreads();
    if (tid == 0) {
        unsigned* bar = b.bar;
        __builtin_amdgcn_s_waitcnt(0);
        unsigned nloc = b.st[0], nx = b.st[1];
        if (nloc == 0u) { xcd_barrier_complete(bar, b.x, nloc, nx); b.st[0] = nloc; b.st[1] = nx; }
        const unsigned old = xb_add(&bar[XB_XSUB(b.x)], 1u);
        const unsigned gen = old / nloc;
        if (old + 1u == (gen + 1u) * nloc) {
            __builtin_amdgcn_fence(__ATOMIC_RELEASE, "agent");
            asm volatile("s_waitcnt vmcnt(0)" ::: "memory");
            const unsigned og = xb_add(&bar[XB_TOP], 1u);
            const unsigned tg = og / nx;
            if (og + 1u == (tg + 1u) * nx) xb_add(&bar[XB_TOPGEN], 1u);
            else XB_SPIN(xb_ld(&bar[XB_TOPGEN]) == tg, bar);
            __builtin_amdgcn_fence(__ATOMIC_ACQUIRE, "agent");
            xb_add(&bar[XB_XGEN(b.x)], 1u);
            asm volatile("s_waitcnt vmcnt(0)" ::: "memory");
        } else {
            XB_SPIN(xb_ld(&bar[XB_XGEN(b.x)]) == gen, bar);
            __builtin_amdgcn_fence(__ATOMIC_ACQUIRE, "agent");
            asm volatile("s_waitcnt vmcnt(0)" ::: "memory");
        }
    }
    __syncthreads();
}

enum { T_MOD = 0, T_TRANS = 1, T_ROW = 2, T_GEMM = 3, T_ATTN = 4 };
struct PhaseDesc { const void* p[8]; int type, sync, i0, i1, i2, i3, i4, i5; };
constexpr int N_PHASES = 19;
struct Args { PhaseDesc ph[N_PHASES]; unsigned* bar; int ph_lo, ph_hi; int probe_mask, pad; };

__device__ __forceinline__ float wave_sum(float v) {
#pragma unroll
    for (int o = 1; o < 64; o <<= 1) v += __shfl_xor(v, o);
    return v;
}
__device__ __forceinline__ unsigned f2bf(float f) { unsigned u = __builtin_bit_cast(unsigned, f); return (u + 0x7fffu + ((u >> 16) & 1u)) >> 16; }
__device__ __forceinline__ unsigned pk2(float lo, float hi) { return f2bf(lo) | (f2bf(hi) << 16); }

struct TrItem { const float* src; bf16_t* dst; int N, K; };
__device__ __forceinline__ void tr_load(f32x4 (&v)[8], const TrItem& t, int lane) {
#pragma unroll
    for (int i = 0; i < 8; ++i) v[i] = *(const f32x4*)(t.src + (size_t)(8 * i + (lane >> 3)) * t.N + (lane & 7) * 4);
}
__device__ __forceinline__ void tr_store(const f32x4 (&v)[8], const TrItem& t, LAS float* scr, int lane) {
#pragma unroll
    for (int i = 0; i < 8; ++i) { LAS float* p = scr + (8 * i + (lane >> 3)) * 33 + (lane & 7) * 4; p[0] = v[i].x; p[1] = v[i].y; p[2] = v[i].z; p[3] = v[i].w; }
    asm volatile("s_waitcnt lgkmcnt(0)" ::: "memory");
    const int c = lane & 7;
#pragma unroll
    for (int j = 0; j < 4; ++j) { const int n = (lane >> 3) + 8 * j; const LAS float* s = scr + (8 * c) * 33 + n;
        u32x4 o; o.x = cvt_pk_bf16(s[0 * 33], s[1 * 33]); o.y = cvt_pk_bf16(s[2 * 33], s[3 * 33]); o.z = cvt_pk_bf16(s[4 * 33], s[5 * 33]); o.w = cvt_pk_bf16(s[6 * 33], s[7 * 33]);
        *(u32x4*)(t.dst + (size_t)n * t.K + 8 * c) = o; }
    asm volatile("s_waitcnt lgkmcnt(0)" ::: "memory");
}

constexpr int I_IN = (DM / 64) * (INC / 32), I_PC = (CWID / 64) * (DM / 32), I_OUT = (DM / 64) * (DM / 32), I_W1 = (DM / 64) * (FF / 32), I_W2 = (FF / 64) * (DM / 32);
constexpr int I_L = I_IN + 2 * I_PC + I_OUT + I_W1 + I_W2;
__device__ __forceinline__ TrItem tr_decode(const PhaseDesc& d, unsigned char* wbase, int pi, int half) {
    constexpr int P_L = I_L / 2;
    const int l = pi / P_L; int r = pi % P_L; unsigned char* wl = wbase + (size_t)l * WL_SZ;
    const float* W; bf16_t* WT; int N, Kd;
    if (r < I_IN / 2) { W = (const float*)d.p[0] + (size_t)l * DM * INC; N = INC; Kd = DM; WT = (bf16_t*)(wl + WL_IN); }
    else if ((r -= I_IN / 2) < I_PC / 2) { W = (const float*)d.p[1] + (size_t)l * CWID * DM; N = DM; Kd = CWID; WT = (bf16_t*)(wl + WL_PC); }
    else if ((r -= I_PC / 2) < I_PC / 2) { W = (const float*)d.p[2] + (size_t)l * CWID * DM; N = DM; Kd = CWID; WT = (bf16_t*)(wl + WL_PA); }
    else if ((r -= I_PC / 2) < I_OUT / 2) { W = (const float*)d.p[3] + (size_t)l * DM * DM; N = DM; Kd = DM; WT = (bf16_t*)(wl + WL_OUT); }
    else if ((r -= I_OUT / 2) < I_W1 / 2) { W = (const float*)d.p[4] + (size_t)l * DM * FF; N = FF; Kd = DM; WT = (bf16_t*)(wl + WL_W1); }
    else { r -= I_W1 / 2; W = (const float*)d.p[5] + (size_t)l * FF * DM; N = DM; Kd = FF; WT = (bf16_t*)(wl + WL_W2); }
    const int nblk = N / 32, kb = 2 * (r / nblk) + half, nb = r % nblk;
    TrItem t; t.src = W + (size_t)(64 * kb) * N + 32 * nb; t.dst = WT + (size_t)(32 * nb) * Kd + 64 * kb; t.N = N; t.K = Kd; return t;
}

template <bool XBF>
__device__ __forceinline__ void row_phase(int gw, int ngw, int lane, bool has_src, bool has_next, bool xout_bf, const bf16_t* src, const float* xin, float* xout,
                                          const float* g_post, const float* gate  , const float* g_pre, const float* shift, const float* scale, bf16_t* xn) {
    constexpr int XW = XBF ? 2 : 4;
    const int cb = 8 * lane;
    u32x4 xr[2][XW], sr[2][2];
    int m0 = gw, m1 = gw; bool pair = false;
    auto pick = [&](int mA, int& a, int& b, bool& pr) { a = mA; const int mB = mA + ngw; pr = (mB < MT) && ((mB >> 13) == (mA >> 13)); b = pr ? mB : mA; };
    auto load_raw = [&](u32x4 (&X)[2][XW], u32x4 (&S)[2][2], int a, int b) {
#pragma unroll
        for (int r = 0; r < 2; ++r) { const size_t m = (size_t)(r ? b : a);
#pragma unroll
            for (int j = 0; j < 2; ++j) {
                if (XBF) X[r][j] = *(const u32x4*)((const bf16_t*)xin + m * DM + cb + 512 * j);
                else { X[r][2 * j] = *(const u32x4*)(xin + m * DM + cb + 512 * j); X[r][2 * j + 1] = *(const u32x4*)(xin + m * DM + cb + 512 * j + 4); }
                if (has_src) S[r][j] = *(const u32x4*)(src + m * DM + cb + 512 * j); else S[r][j] = (u32x4){0u, 0u, 0u, 0u}; } }
    };
    if (gw >= MT) return;
    pick(gw, m0, m1, pair);
    load_raw(xr, sr, m0, m1);
    f32x4 gp[4], gt[4], gq[4], sh[4], sc[4]; int bcur = m0 >> 13;
#pragma unroll
    for (int jj = 0; jj < 4; ++jj) { const int c = cb + 512 * (jj >> 1) + 4 * (jj & 1);
        gp[jj] = *(const f32x4*)(g_post + c); gt[jj] = *(const f32x4*)(gate + (size_t)bcur * (NMOD * DM) + c);
        gq[jj] = *(const f32x4*)(g_pre + c); sh[jj] = *(const f32x4*)(shift + (size_t)bcur * (NMOD * DM) + c); sc[jj] = *(const f32x4*)(scale + (size_t)bcur * (NMOD * DM) + c); }
    for (;;) {
        const int mn = m0 + (pair ? 2 : 1) * ngw; const bool more = mn < MT;
        int n0, n1; bool npair; pick(more ? mn : m0, n0, n1, npair);
        u32x4 xq[2][XW], sq[2][2];
        load_raw(xq, sq, n0, n1);
        const int b = m0 >> 13;
        if (b != bcur) {
            bcur = b;
#pragma unroll
            for (int jj = 0; jj < 4; ++jj) { const int c = cb + 512 * (jj >> 1) + 4 * (jj & 1);
                gt[jj] = *(const f32x4*)(gate + (size_t)b * (NMOD * DM) + c); sh[jj] = *(const f32x4*)(shift + (size_t)b * (NMOD * DM) + c); sc[jj] = *(const f32x4*)(scale + (size_t)b * (NMOD * DM) + c); }
        }
        __builtin_amdgcn_sched_barrier(0);
        f32x4 x[2][4];
#pragma unroll
        for (int r = 0; r < 2; ++r)
#pragma unroll
            for (int j = 0; j < 2; ++j) {
                if (XBF) { const u32x4 w = xr[r][j]; x[r][2 * j] = (f32x4){bf_lo(w.x), bf_hi(w.x), bf_lo(w.y), bf_hi(w.y)}; x[r][2 * j + 1] = (f32x4){bf_lo(w.z), bf_hi(w.z), bf_lo(w.w), bf_hi(w.w)}; }
                else { x[r][2 * j] = __builtin_bit_cast(f32x4, xr[r][2 * j]); x[r][2 * j + 1] = __builtin_bit_cast(f32x4, xr[r][2 * j + 1]); } }
        if (has_src) {
            f32x4 s[2][4]; float ss[2];
#pragma unroll
            for (int r = 0; r < 2; ++r) { ss[r] = 0.f;
#pragma unroll
                for (int j = 0; j < 2; ++j) { const u32x4 w = sr[r][j]; s[r][2 * j] = (f32x4){bf_lo(w.x), bf_hi(w.x), bf_lo(w.y), bf_hi(w.y)}; s[r][2 * j + 1] = (f32x4){bf_lo(w.z), bf_hi(w.z), bf_lo(w.w), bf_hi(w.w)}; }
#pragma unroll
                for (int jj = 0; jj < 4; ++jj) ss[r] += (s[r][jj].x * s[r][jj].x + s[r][jj].y * s[r][jj].y) + (s[r][jj].z * s[r][jj].z + s[r][jj].w * s[r][jj].w); }
#pragma unroll
            for (int o = 1; o < 64; o <<= 1) { ss[0] += __shfl_xor(ss[0], o); ss[1] += __shfl_xor(ss[1], o); }
#pragma unroll
            for (int r = 0; r < 2; ++r) { const float rstd = __builtin_amdgcn_rsqf(ss[r] * (1.0f / DM) + EPS); const bool live = (r == 0) || pair; const size_t m = (size_t)(r ? m1 : m0);
#pragma unroll
                for (int jj = 0; jj < 4; ++jj) x[r][jj] = x[r][jj] + gt[jj] * (s[r][jj] * rstd * gp[jj]);
#pragma unroll
                for (int j = 0; j < 2; ++j) {
                    if (xout_bf) { u32x4 w; w.x = cvt_pk_bf16(x[r][2 * j].x, x[r][2 * j].y); w.y = cvt_pk_bf16(x[r][2 * j].z, x[r][2 * j].w); w.z = cvt_pk_bf16(x[r][2 * j + 1].x, x[r][2 * j + 1].y); w.w = cvt_pk_bf16(x[r][2 * j + 1].z, x[r][2 * j + 1].w);
                        if (live) st_wt16((bf16_t*)xout + m * DM + cb + 512 * j, w);
                        x[r][2 * j] = (f32x4){bf_lo(w.x), bf_hi(w.x), bf_lo(w.y), bf_hi(w.y)}; x[r][2 * j + 1] = (f32x4){bf_lo(w.z), bf_hi(w.z), bf_lo(w.w), bf_hi(w.w)}; }
                    else if (live) { *(f32x4*)(xout + m * DM + cb + 512 * j) = x[r][2 * j]; *(f32x4*)(xout + m * DM + cb + 512 * j + 4) = x[r][2 * j + 1]; } } }
        }
        if (has_next) {
            float ss[2];
#pragma unroll
            for (int r = 0; r < 2; ++r) { ss[r] = 0.f;
#pragma unroll
                for (int jj = 0; jj < 4; ++jj) ss[r] += (x[r][jj].x * x[r][jj].x + x[r][jj].y * x[r][jj].y) + (x[r][jj].z * x[r][jj].z + x[r][jj].w * x[r][jj].w); }
#pragma unroll
            for (int o = 1; o < 64; o <<= 1) { ss[0] += __shfl_xor(ss[0], o); ss[1] += __shfl_xor(ss[1], o); }
#pragma unroll
            for (int r = 0; r < 2; ++r) { const float rstd = __builtin_amdgcn_rsqf(ss[r] * (1.0f / DM) + EPS); const bool live = (r == 0) || pair; const size_t m = (size_t)(r ? m1 : m0);
#pragma unroll
                for (int j = 0; j < 2; ++j) { const f32x4 h0 = (x[r][2 * j] * rstd * gq[2 * j]) * (sc[2 * j] + 1.0f) + sh[2 * j], h1 = (x[r][2 * j + 1] * rstd * gq[2 * j + 1]) * (sc[2 * j + 1] + 1.0f) + sh[2 * j + 1];
                    u32x4 w; w.x = cvt_pk_bf16(h0.x, h0.y); w.y = cvt_pk_bf16(h0.z, h0.w); w.z = cvt_pk_bf16(h1.x, h1.y); w.w = cvt_pk_bf16(h1.z, h1.w);
                    if (live) st_wt16(xn + m * DM + cb + 512 * j, w); } }
        }
        if (!more) break;
#pragma unroll
        for (int r = 0; r < 2; ++r) {
#pragma unroll
            for (int j = 0; j < XW; ++j) xr[r][j] = xq[r][j];
            sr[r][0] = sq[r][0]; sr[r][1] = sq[r][1]; }
        m0 = n0; m1 = n1; pair = npair;
    }
}

constexpr int LDS_TOTAL = 131072 + 1024;

__global__ void __launch_bounds__(512, 2) mega_fwd(Args args) {
    __shared__ __attribute__((aligned(16))) unsigned char lds_raw[LDS_TOTAL];
    LAS unsigned char* lds = (LAS unsigned char*)lds_raw;
    volatile LAS unsigned* MISC = (volatile LAS unsigned*)(lds + 131072 + 512);
    if (threadIdx.x < 4) MISC[threadIdx.x] = 0u;
    __syncthreads();
    XcdBarrier xbar = xcd_barrier_post(args.bar, MISC, (int)threadIdx.x);
    unsigned long long probe_acc = 0ull;
    for (int ph = args.ph_lo; ph < args.ph_hi; ++ph) {
        int tid = threadIdx.x; asm volatile("" : "+v"(tid));
        const int lane = tid & 63; const int wave = __builtin_amdgcn_readfirstlane(tid >> 6);
        const int G = gridDim.x, bx = blockIdx.x;
        const int gw = bx * 8 + wave, ngw = G * 8;
        const PhaseDesc& d = args.ph[ph];
        const int type = d.type;
#if PROBE_TIMING
        const unsigned long long t_begin = __builtin_amdgcn_s_memrealtime();
#endif
        if (type == T_GEMM) {
            pg8::Gemm g{(const bf16_t*)d.p[0], (const bf16_t*)d.p[1], MT, d.i0, d.i1, d.i2, (d.i4 == 6) ? 1536 * 2 : 0, (d.i4 == 6) ? (int)(WL_PA - WL_PC) : 0};
            pg8::Epi E{(bf16_t*)d.p[2], d.i3, d.i4, (const bf16_t*)d.p[3], d.i5};
            pg8::StaticOrder S; S.init(MT, g.N, G, bx);
            pg8::gemm_phase(lds, g, S, E, tid);
        } else if (type == T_ATTN) {
            bf16_t* PROJ = (bf16_t*)d.p[0];
            for (int u = gw; u < 16 * 256; u += ngw) { const int bh = u >> 8, qblk = u & 255; att::attn_wave_unit(bh >> 3, bh & 7, qblk, PROJ, lds + wave * 16384, lane); }
            const float* cw = (const float*)d.p[1];
            const int ch = lane * 8;
            float w0[8], w1[8], w2[8];
#pragma unroll
            for (int i = 0; i < 8; ++i) { w0[i] = cw[ch + i]; w1[i] = cw[CWID + ch + i]; w2[i] = cw[2 * CWID + ch + i]; }
            for (int chunk = gw; chunk < MT / 8; chunk += ngw) {
                const int m0 = chunk * 8; const int tpos = m0 & (SEQ - 1);
                const int mlo = (tpos >= 2) ? m0 - 2 : m0;
                u32x4 cc[10], uu[10], bb[8];
#pragma unroll
                for (int i = 0; i < 2; ++i) { cc[i] = *(const u32x4*)(PROJ + (size_t)(mlo + i) * INC + 512 + ch); uu[i] = *(const u32x4*)(PROJ + (size_t)(mlo + i) * INC + 1024 + ch); }
#pragma unroll
                for (int i = 0; i < 8; ++i) { const size_t m = (size_t)(m0 + i); cc[2 + i] = *(const u32x4*)(PROJ + m * INC + 512 + ch); uu[2 + i] = *(const u32x4*)(PROJ + m * INC + 1024 + ch); bb[i] = *(const u32x4*)(PROJ + m * INC + ch); }
                float v2[8], v1[8];
                const float hz = (tpos >= 2) ? 1.f : 0.f;
#pragma unroll
                for (int i = 0; i < 4; ++i) { v2[2 * i] = hz * bf_lo(cc[0][i]) * bf_lo(uu[0][i]); v2[2 * i + 1] = hz * bf_hi(cc[0][i]) * bf_hi(uu[0][i]); v1[2 * i] = hz * bf_lo(cc[1][i]) * bf_lo(uu[1][i]); v1[2 * i + 1] = hz * bf_hi(cc[1][i]) * bf_hi(uu[1][i]); }
#pragma unroll
                for (int i8 = 0; i8 < 8; ++i8) {
                    const size_t m = (size_t)(m0 + i8);
                    float v0[8], y[8];
#pragma unroll
                    for (int i = 0; i < 4; ++i) { v0[2 * i] = bf_lo(cc[2 + i8][i]) * bf_lo(uu[2 + i8][i]); v0[2 * i + 1] = bf_hi(cc[2 + i8][i]) * bf_hi(uu[2 + i8][i]); }
#pragma unroll
                    for (int i = 0; i < 8; ++i) y[i] = w0[i] * v2[i] + w1[i] * v1[i] + w2[i] * v0[i];
                    u32x4 o;
#pragma unroll
                    for (int i = 0; i < 4; ++i) o[i] = cvt_pk_bf16(bf_lo(bb[i8][i]) * y[2 * i], bf_hi(bb[i8][i]) * y[2 * i + 1]);
                    *(u32x4*)(PROJ + m * INC + ch) = o;
#pragma unroll
                    for (int i = 0; i < 8; ++i) { v2[i] = v1[i]; v1[i] = v0[i]; }
                }
            }
        } else if (type == T_ROW) {
            if (d.i4 != 0) row_phase<true>(gw, ngw, lane, d.i0 != 0, d.i1 != 0, d.i5 != 0, (const bf16_t*)d.p[0], (const float*)d.p[1], (float*)d.p[2], (const float*)d.p[3], (const float*)d.p[4],
                      (const float*)d.p[5], (const float*)d.p[6], (const float*)d.p[6] + DM, (bf16_t*)d.p[7]);
            else row_phase<false>(gw, ngw, lane, d.i0 != 0, d.i1 != 0, d.i5 != 0, (const bf16_t*)d.p[0], (const float*)d.p[1], (float*)d.p[2], (const float*)d.p[3], (const float*)d.p[4],
                      (const float*)d.p[5], (const float*)d.p[6], (const float*)d.p[6] + DM, (bf16_t*)d.p[7]);
        } else if (type == T_MOD) {
            const float* w_ada = (const float*)d.p[0]; const float* b_ada = (const float*)d.p[1]; float* MOD = (float*)d.p[2]; const float* cvec = (const float*)d.p[3];
            for (int it = bx; it < 256; it += G) {
                const int l = it >> 7, n0 = (it & 127) * 48, ln = lane < 48 ? lane : 47;
                float a0 = 0.f, a1 = 0.f;
                const float* wp = w_ada + ((size_t)l * DM + wave * 128) * (NMOD * DM) + n0 + ln;
                const float* c0p = cvec + wave * 128; const float* c1p = cvec + DM + wave * 128;
                float cr[2][2];
                cr[0][0] = c0p[lane]; cr[0][1] = c0p[64 + lane]; cr[1][0] = c1p[lane]; cr[1][1] = c1p[64 + lane];
#pragma unroll
                for (int kb = 0; kb < 128; kb += 32) {
                    float wv[32];
#pragma unroll
                    for (int j = 0; j < 32; ++j) wv[j] = wp[(size_t)(kb + j) * (NMOD * DM)];
                    __builtin_amdgcn_sched_barrier(0);
#pragma unroll
                    for (int j = 0; j < 32; ++j) { const int k = kb + j;
                        const float c0 = __builtin_bit_cast(float, __builtin_amdgcn_readlane(__builtin_bit_cast(int, cr[0][k >> 6]), k & 63));
                        const float c1 = __builtin_bit_cast(float, __builtin_amdgcn_readlane(__builtin_bit_cast(int, cr[1][k >> 6]), k & 63));
                        a0 += wv[j] * c0; a1 += wv[j] * c1; }
                }
                LAS float* red = (LAS float*)lds;
                if (lane < 48) { red[(wave * 2 + 0) * 48 + lane] = a0; red[(wave * 2 + 1) * 48 + lane] = a1; }
                __syncthreads();
                if (tid < 96) { const int b = tid / 48, col = tid % 48; float s = b_ada[(size_t)l * (NMOD * DM) + n0 + col];
#pragma unroll
                    for (int w = 0; w < 8; ++w) s += red[(w * 2 + b) * 48 + col];
                    MOD[((size_t)l * 2 + b) * (NMOD * DM) + n0 + col] = s; }
                __syncthreads();
            }
        } else {
            LAS float* scr = (LAS float*)(lds + wave * 16384);
            unsigned char* wbase = (unsigned char*)d.p[6];
            for (int pi = gw; pi < I_L; pi += ngw) {
                f32x4 va[8], vb[8];
                const TrItem ta = tr_decode(d, wbase, pi, 0); tr_load(va, ta, lane);
                const TrItem tb = tr_decode(d, wbase, pi, 1); tr_load(vb, tb, lane);
                tr_store(va, ta, scr, lane);
                tr_store(vb, tb, scr, lane);
            }
        }
#if PROBE_TIMING
        if ((args.probe_mask >> type) & 1) probe_acc += __builtin_amdgcn_s_memrealtime() - t_begin;
        const unsigned long long t_sync = __builtin_amdgcn_s_memrealtime();
#endif
        if (ph + 1 < args.ph_hi) {
            if (d.sync == 2) cg::this_grid().sync();
            else if (d.sync == 1) xcd_barrier(xbar, tid);
        }
#if PROBE_TIMING
        if ((args.probe_mask >> 8) & 1) probe_acc += __builtin_amdgcn_s_memrealtime() - t_sync;
#endif
    }
#if PROBE_TIMING
    { const unsigned long long t0 = __builtin_amdgcn_s_memrealtime(); while (__builtin_amdgcn_s_memrealtime() - t0 < probe_acc) __builtin_amdgcn_s_sleep(8); }
#endif
}

static void build_phases(Args& a, void* const* d_in, void* d_out, void* d_ws) {
    unsigned char* ws = (unsigned char*)d_ws;
    float* MOD = (float*)(ws + WS_MOD); bf16_t* XN = (bf16_t*)(ws + WS_XN); bf16_t* PROJ = (bf16_t*)(ws + WS_PROJ);
    const float* x_in = (const float*)d_in[0];
    const float* g_pre_mix = (const float*)d_in[4]; const float* g_post_mix = (const float*)d_in[5]; const float* g_pre_mlp = (const float*)d_in[6]; const float* g_post_mlp = (const float*)d_in[7];
    float* out = (float*)d_out;
    float* XB0 = (float*)d_out;
    float* XT = (float*)(ws + WS_PROJ + 128 * MiB);
    int n = 0;
    auto add = [&](int type, int sync) -> PhaseDesc& { PhaseDesc& d = a.ph[n++]; d.type = type; d.sync = sync; return d; };
    { PhaseDesc& d = add(T_MOD, 0); d.p[0] = d_in[2]; d.p[1] = d_in[3]; d.p[2] = MOD; d.p[3] = d_in[1]; }
    { PhaseDesc& d = add(T_TRANS, 1); d.p[0] = d_in[8]; d.p[1] = d_in[10]; d.p[2] = d_in[11]; d.p[3] = d_in[12]; d.p[4] = d_in[13]; d.p[5] = d_in[14]; d.p[6] = ws + WS_W; }
    { PhaseDesc& d = add(T_ROW, 1); d.i0 = 0; d.i1 = 1; d.p[0] = XN; d.p[1] = x_in; d.p[2] = out; d.p[3] = g_pre_mix; d.p[4] = MOD; d.p[5] = g_pre_mix; d.p[6] = MOD + 0 * DM; d.p[7] = XN; }
    for (int l = 0; l < 2; ++l) {
        const unsigned char* wl = ws + WS_W + (size_t)l * WL_SZ;
        const float* modl = MOD + (size_t)l * 2 * (NMOD * DM);
        auto gemm = [&](const bf16_t* A, const void* Bt, int N, int K, int lda, bf16_t* O, int ldc, int mode, const bf16_t* Gt, int ldg, int sync) {
            PhaseDesc& d = add(T_GEMM, sync); d.p[0] = A; d.p[1] = Bt; d.p[2] = O; d.p[3] = Gt ? Gt : O; d.i0 = N; d.i1 = K; d.i2 = lda; d.i3 = ldc; d.i4 = mode; d.i5 = ldg; };
        gemm(XN, wl + WL_IN, INC, DM, DM, PROJ, INC, 1, nullptr, 0, 1);
        { PhaseDesc& d = add(T_ATTN, 1); d.p[0] = PROJ; d.p[1] = (const float*)d_in[9] + (size_t)l * 3 * CWID; }
        gemm(PROJ, wl + WL_PC, DM, CWID, INC, XN, DM, 6, PROJ + 4096, INC, 1);
        gemm(XN, wl + WL_OUT, DM, DM, DM, PROJ, DM, 0, nullptr, 0, 1);
        { PhaseDesc& d = add(T_ROW, 1); d.i0 = 1; d.i1 = 1; d.p[0] = PROJ; d.p[1] = (l == 0) ? x_in : XB0; d.p[2] = (l == 0) ? XB0 : XT; d.i4 = (l == 0) ? 0 : 1; d.i5 = 1; d.p[3] = g_post_mix + (size_t)l * DM; d.p[4] = modl + 2 * DM;
          d.p[5] = g_pre_mlp + (size_t)l * DM; d.p[6] = modl + 3 * DM; d.p[7] = XN; }
        gemm(XN, wl + WL_W1, FF, DM, DM, PROJ, FF, 2, nullptr, 0, 1);
        gemm(PROJ, wl + WL_W2, DM, FF, FF, XN, DM, 0, nullptr, 0, 1);
        { const int ln = (l + 1 < 2) ? l + 1 : l; const float* modn = MOD + (size_t)ln * 2 * (NMOD * DM);
          PhaseDesc& d = add(T_ROW, 1); d.i0 = 1; d.i1 = (l == 0) ? 1 : 0; d.p[0] = XN; d.p[1] = (l == 0) ? XB0 : XT; d.p[2] = (l == 0) ? XB0 : out; d.i4 = 1; d.i5 = (l == 0) ? 1 : 0; d.p[3] = g_post_mlp + (size_t)l * DM; d.p[4] = modl + 5 * DM;
          d.p[5] = g_pre_mix + (size_t)ln * DM; d.p[6] = modn + 0 * DM; d.p[7] = XN; }
    }
    if (n != N_PHASES) fprintf(stderr, "phase count mismatch: %d vs %d\n", n, N_PHASES);
}

extern "C" void kernel_launch(void* const* d_in, const int* in_sizes, int n_in, void* d_out, int out_size, void* d_ws, size_t ws_size, hipStream_t stream) {
    static int grid = 0;
    if (grid == 0) {
        int dev = 0, cus = 0, per_cu = 0;
        (void)hipGetDevice(&dev);
        (void)hipDeviceGetAttribute(&cus, hipDeviceAttributeMultiprocessorCount, dev);
        if (hipOccupancyMaxActiveBlocksPerMultiprocessor(&per_cu, (const void*)mega_fwd, 512, 0) != hipSuccess || per_cu < 1) per_cu = 1;
        (void)hipGetLastError();
        if (per_cu > 1) per_cu = 1;
        grid = cus * per_cu;
        if (ws_size < WS_END) fprintf(stderr, "kernel_launch: workspace too small: %zu < %zu\n", ws_size, (size_t)WS_END);
    }
    Args a{};
    build_phases(a, d_in, d_out, d_ws);
    a.bar = (unsigned*)((unsigned char*)d_ws + WS_BAR); a.probe_mask = PROBE_MASK;
    (void)hipMemsetAsync(a.bar, 0, XCD_BAR_WORDS * 4, stream);
#if MULTI_LAUNCH
    for (int ph = 0; ph < N_PHASES;) { int e = ph; while (!a.ph[e].sync) ++e; a.ph_lo = ph; a.ph_hi = e + 1; hipLaunchKernelGGL(mega_fwd, dim3(grid), dim3(512), 0, stream, a); ph = e + 1; }
#else
    a.ph_lo = 0; a.ph_hi = N_PHASES;
    void* kargs[] = {&a};
    hipError_t e = hipLaunchCooperativeKernel((const void*)mega_fwd, dim3(grid), dim3(512), kargs, 0, stream);
    if (e != hipSuccess) fprintf(stderr, "cooperative launch failed: %s (grid %d)\n", hipGetErrorString(e), grid);
#endif
}
```
